# Optimizing an MI355X kernel written in HIP

```python
import jax, jax.numpy as jnp
from jax import lax
import numpy as np

D_MODEL = 1024
BATCH = 4
SEQ = 4096
DEPTH = 2
DEC_BATCH = 8
DEC_SEQ = 2048
PAST_LEN = 128

N_MIXERS = 2
CONV_WIDTH = 3
RET_HEADS = D_MODEL // 256
RET_QK_DIM = D_MODEL // RET_HEADS
RET_V_DIM = 2 * RET_QK_DIM
RET_QK_WIDTH = RET_HEADS * RET_QK_DIM
RET_V_WIDTH = RET_HEADS * RET_V_DIM
CHUNK = 128
D_FF = 4 * D_MODEL
NORM_EPS = 1e-6
ROPE_BASE = 10000.0

kernel_name = 'bidir_shortconv_retention_hybrid_encoder'


def rms_norm(x, g):
    xf = x.astype(jnp.float32)
    y = xf * lax.rsqrt(jnp.mean(xf * xf, axis=-1, keepdims=True) + NORM_EPS)
    return (y * g.astype(jnp.float32)).astype(x.dtype)


def short_conv_mixer(x, w_in, conv_w, conv_b, w_out):
    s = x.shape[1]
    h, gate_b, gate_c = jnp.split(x @ w_in, 3, axis=-1)
    u = gate_c * h
    pad = CONV_WIDTH // 2
    up = jnp.pad(u, ((0, 0), (pad, pad), (0, 0)))
    z = conv_b + sum(up[:, j:j + s] * conv_w[j] for j in range(CONV_WIDTH))
    return (gate_b * z) @ w_out


def rotary(x, pos):
    half = x.shape[-1] // 2
    inv = ROPE_BASE ** (-jnp.arange(half, dtype=jnp.float32) / half)
    ang = pos[:, None] * inv[None, :]
    cos, sin = jnp.cos(ang), jnp.sin(ang)
    x1, x2 = x[..., :half], x[..., half:]
    return jnp.concatenate([x1 * cos - x2 * sin, x1 * sin + x2 * cos], axis=-1)


def retention_log_decays():
    h = jnp.arange(RET_HEADS, dtype=jnp.float32)
    fwd = jnp.log(1.0 - jnp.power(2.0, -5.0 - h))
    bwd = jnp.log(1.0 - jnp.power(2.0, -5.5 - h))
    return fwd, bwd


def retention_scan(q, k, v, log_gamma, strict):
    b, h, s, dk = q.shape
    dv = v.shape[-1]
    n = s // CHUNK

    def to_chunks(t):
        return t.reshape(b, h, n, CHUNK, t.shape[-1]).transpose(2, 0, 1, 3, 4)

    qc, kc, vc = to_chunks(q), to_chunks(k), to_chunks(v)
    idx = jnp.arange(CHUNK, dtype=jnp.float32)
    diff = idx[:, None] - idx[None, :]
    keep = diff > 0 if strict else diff >= 0
    intra_decay = jnp.where(keep, jnp.exp(log_gamma[:, None, None] * jnp.maximum(diff, 0.0)), 0.0)
    q_decay = jnp.exp(log_gamma[:, None] * (idx + 1.0))[..., None]
    k_decay = jnp.exp(log_gamma[:, None] * (CHUNK - 1.0 - idx))[..., None]
    chunk_decay = jnp.exp(log_gamma * CHUNK)[:, None, None]

    def step(state, qkv):
        qi, ki, vi = qkv
        scores = jnp.einsum('bhid,bhjd->bhij', qi, ki) * intra_decay
        out = jnp.einsum('bhij,bhjv->bhiv', scores, vi)
        out = out + jnp.einsum('bhid,bhdv->bhiv', qi * q_decay, state)
        state = state * chunk_decay + jnp.einsum('bhjd,bhjv->bhdv', ki * k_decay, vi)
        return state, out

    state0 = jnp.zeros((b, h, dk, dv), jnp.float32)
    _, out = lax.scan(step, state0, (qc, kc, vc))
    return out.transpose(1, 2, 0, 3, 4).reshape(b, h, s, dv)


def retention_mixer(x, w_qkvg, w_o):
    b, s, _ = x.shape
    q, k, v, g = jnp.split(x @ w_qkvg, [RET_QK_WIDTH, 2 * RET_QK_WIDTH, 2 * RET_QK_WIDTH + RET_V_WIDTH], axis=-1)

    def heads(t, d):
        return t.reshape(b, s, RET_HEADS, d).transpose(0, 2, 1, 3).astype(jnp.float32)

    pos = jnp.arange(s, dtype=jnp.float32)
    q = rotary(heads(q, RET_QK_DIM), pos) * (RET_QK_DIM ** -0.5)
    k = rotary(heads(k, RET_QK_DIM), pos)
    v = heads(v, RET_V_DIM)
    lg_fwd, lg_bwd = retention_log_decays()
    rev = lambda t: jnp.flip(t, axis=2)
    o_fwd = retention_scan(q, k, v, lg_fwd, strict=False)
    o_bwd = rev(retention_scan(rev(q), rev(k), rev(v), lg_bwd, strict=True))
    o = o_fwd + o_bwd
    o = o - jnp.mean(o, axis=-1, keepdims=True)
    o = o * lax.rsqrt(jnp.mean(o * o, axis=-1, keepdims=True) + NORM_EPS)
    o = o.transpose(0, 2, 1, 3).reshape(b, s, RET_V_WIDTH).astype(x.dtype)
    return (jax.nn.silu(g) * o) @ w_o


def sq_relu_mlp(x, w_up, w_down):
    return jnp.square(jax.nn.relu(x @ w_up)) @ w_down


def encoder_trunk(x, norm_mix_0, w_in_conv_0, conv_w_0, conv_b_0, w_out_conv_0, norm_mlp_0, w_up_0, w_down_0,
                  norm_mix_1, w_qkvg_1, w_o_1, norm_mlp_1, w_up_1, w_down_1, norm_final):
    mixer_fns = [
        lambda t: short_conv_mixer(t, w_in_conv_0, conv_w_0, conv_b_0, w_out_conv_0),
        lambda t: retention_mixer(t, w_qkvg_1, w_o_1),
    ]
    mix_norms = [norm_mix_0, norm_mix_1]
    mlp_norms = [norm_mlp_0, norm_mlp_1]
    ups = [w_up_0, w_up_1]
    downs = [w_down_0, w_down_1]
    for i in range(DEPTH):
        x = x + mixer_fns[i % N_MIXERS](rms_norm(x, mix_norms[i]))
        x = x + sq_relu_mlp(rms_norm(x, mlp_norms[i]), ups[i], downs[i])
    return rms_norm(x, norm_final)


def setup_inputs(seed: int = 0) -> dict:
    key = jax.random.key(seed)
    ks = jax.random.split(key, 20)
    f32 = jnp.float32

    def w(k, shape, fan_in):
        return jax.random.normal(k, shape, f32) * (fan_in ** -0.5)

    def gain(k):
        return jnp.ones((D_MODEL,), f32) + 0.02 * jax.random.normal(k, (D_MODEL,), f32)

    return {
        'x_prompt': jax.random.normal(ks[0], (BATCH, SEQ, D_MODEL), f32),
        'x_sample': jax.random.normal(ks[1], (DEC_BATCH, DEC_SEQ, D_MODEL), f32),
        'norm_mix_0': gain(ks[2]),
        'w_in_conv_0': w(ks[3], (D_MODEL, 3 * D_MODEL), D_MODEL),
        'conv_w_0': w(ks[4], (CONV_WIDTH, D_MODEL), CONV_WIDTH),
        'conv_b_0': 0.02 * jax.random.normal(ks[5], (D_MODEL,), f32),
        'w_out_conv_0': w(ks[6], (D_MODEL, D_MODEL), D_MODEL),
        'norm_mlp_0': gain(ks[7]),
        'w_up_0': w(ks[8], (D_MODEL, D_FF), D_MODEL),
        'w_down_0': w(ks[9], (D_FF, D_MODEL), D_FF),
        'norm_mix_1': gain(ks[10]),
        'w_qkvg_1': w(ks[11], (D_MODEL, 2 * RET_QK_WIDTH + 2 * RET_V_WIDTH), D_MODEL),
        'w_o_1': w(ks[12], (RET_V_WIDTH, D_MODEL), RET_V_WIDTH),
        'norm_mlp_1': gain(ks[13]),
        'w_up_1': w(ks[14], (D_MODEL, D_FF), D_MODEL),
        'w_down_1': w(ks[15], (D_FF, D_MODEL), D_FF),
        'norm_final': gain(ks[16]),
    }


def reference(x_prompt, x_sample, norm_mix_0, w_in_conv_0, conv_w_0, conv_b_0, w_out_conv_0, norm_mlp_0,
              w_up_0, w_down_0, norm_mix_1, w_qkvg_1, w_o_1, norm_mlp_1, w_up_1, w_down_1, norm_final):
    y_prompt = encoder_trunk(x_prompt, norm_mix_0, w_in_conv_0, conv_w_0, conv_b_0, w_out_conv_0, norm_mlp_0,
                             w_up_0, w_down_0, norm_mix_1, w_qkvg_1, w_o_1, norm_mlp_1, w_up_1, w_down_1,
                             norm_final)
    y_sample = encoder_trunk(x_sample, norm_mix_0, w_in_conv_0, conv_w_0, conv_b_0, w_out_conv_0, norm_mlp_0,
                             w_up_0, w_down_0, norm_mix_1, w_qkvg_1, w_o_1, norm_mlp_1, w_up_1, w_down_1,
                             norm_final)
    return (y_prompt, y_sample)
```

```cpp
#include <hip/hip_runtime.h>
#include <hip/hip_cooperative_groups.h>
#include <cstdio>
namespace cg = cooperative_groups;

#define LAS __attribute__((address_space(3)))
typedef unsigned short bf16_t;
typedef short bf16x8 __attribute__((ext_vector_type(8)));
typedef float f32x4 __attribute__((ext_vector_type(4)));
typedef float f32x2 __attribute__((ext_vector_type(2)));
typedef unsigned u32x4 __attribute__((ext_vector_type(4)));
typedef unsigned u32x2 __attribute__((ext_vector_type(2)));

constexpr int D = 1024, MG = 16384  , FF = 4096, SLAB = 8192, DVW = 2048;
constexpr float EPS = 1e-6f;
constexpr size_t MiB = 1u << 20;
constexpr size_t WS_CTL = 0, CTL_ZERO_BYTES = 65536;
constexpr size_t WS_SSP = 1 * MiB;
constexpr size_t WS_WIN = 8 * MiB, WS_WOUT = 14 * MiB, WS_WUP0 = 16 * MiB, WS_WDN0 = 24 * MiB, WS_WQKG = 32 * MiB, WS_WV = 40 * MiB, WS_WO = 44 * MiB, WS_WUP1 = 48 * MiB, WS_WDN1 = 56 * MiB;
constexpr size_t WS_XB = 64 * MiB;
constexpr size_t WS_BIG = 96 * MiB;
constexpr size_t WS_U = WS_BIG, WS_GB = WS_BIG + 32 * MiB, WS_A2 = WS_BIG + 64 * MiB;
constexpr size_t WS_HID = WS_BIG;
constexpr size_t WS_A3 = WS_BIG;
constexpr size_t WS_Q = WS_BIG + 64 * MiB, WS_K = WS_BIG + 80 * MiB, WS_VT = WS_BIG + 96 * MiB;
constexpr size_t WS_ROPE = 224 * MiB;
constexpr size_t WS_ST = 228 * MiB;
constexpr size_t WS_END = 256 * MiB;
constexpr int CW_FIN = 8192;
constexpr int CW_BAR = 4096;
constexpr int LDS_BYTES = 158720;
constexpr int MISC_OFF = 155648, RTAB_OFF = 156160;

__device__ __forceinline__ unsigned cvt_pk_bf16(float lo, float hi) { unsigned r; asm volatile("v_cvt_pk_bf16_f32 %0, %1, %2" : "=v"(r) : "v"(lo), "v"(hi)); return r; }
__device__ __forceinline__ float shx(float v, int mask, int lane) { return __builtin_bit_cast(float, __builtin_amdgcn_ds_bpermute((lane ^ mask) << 2, __builtin_bit_cast(int, v))); }
__device__ __forceinline__ unsigned f2bf_rne(float f) { const unsigned u = __float_as_uint(f); return (u + 0x7fffu + ((u >> 16) & 1u)) >> 16; }
__device__ __forceinline__ float bf_lo(unsigned w) { return __uint_as_float(w << 16); }
__device__ __forceinline__ float bf_hi(unsigned w) { return __uint_as_float(w & 0xffff0000u); }

#define XB_TMO      128
#define XB_XCNT(j)  (256  + 64 * (j))
#define XB_XSUB(j)  (1280 + 64 * (j))
#define XB_XGEN(j)  (2304 + 64 * (j))
#define XB_TOP      3328
#define XB_TOPGEN   3392
#define XCD_BAR_WORDS 3456
#define XB_SPIN_CAP (1u << 20)
__device__ __forceinline__ unsigned xb_ld(unsigned* p)              { return __hip_atomic_load(p, __ATOMIC_RELAXED, __HIP_MEMORY_SCOPE_AGENT); }
__device__ __forceinline__ unsigned xb_add(unsigned* p, unsigned v) { return __hip_atomic_fetch_add(p, v, __ATOMIC_RELAXED, __HIP_MEMORY_SCOPE_AGENT); }
__device__ __forceinline__ unsigned xb_xcc_id() { return (unsigned)__builtin_amdgcn_s_getreg((3 << 11) | 20) & 0xFu; }
#define XB_SPIN(cond, bar) do { unsigned _sp = 0; while (cond) { __builtin_amdgcn_s_sleep(1); \
    if ((++_sp & 255u) == 0u) { if (xb_ld(&(bar)[XB_TMO])) break; if (_sp > XB_SPIN_CAP) { atomicAdd(&(bar)[XB_TMO], 1u); break; } } } } while (0)
struct XcdBarrier { unsigned* bar; unsigned x; volatile LAS unsigned* st; };
__device__ __forceinline__ XcdBarrier xcd_barrier_post(unsigned* bar, volatile LAS unsigned* st) {
    XcdBarrier b; b.bar = bar; b.x = xb_xcc_id(); b.st = st;
    if (threadIdx.x == 0) (void)xb_add(&bar[XB_XCNT(b.x)], 1u);
    return b;
}
__device__ __forceinline__ void xcd_barrier_complete(unsigned* bar, unsigned x, unsigned& nloc, unsigned& nx) {
    const unsigned G = gridDim.x * gridDim.y * gridDim.z;
    unsigned sum, cnt, mine, sp = 0u;
    for (;;) {
        sum = 0u; cnt = 0u; mine = 0u;
#pragma unroll
        for (unsigned j = 0; j < 16; ++j) { const unsigned c = xb_ld(&bar[XB_XCNT(j)]); sum += c; cnt += (c > 0u) ? 1u : 0u; mine = (j == x) ? c : mine; }
        if (sum == G) break;
        __builtin_amdgcn_s_sleep(1);
        if ((++sp & 255u) == 0u) { if (xb_ld(&bar[XB_TMO])) break; if (sp > XB_SPIN_CAP) { atomicAdd(&bar[XB_TMO], 1u); break; } }
    }
    nloc = mine > 0u ? mine : 1u; nx = cnt > 0u ? cnt : 1u;
}
__device__ __forceinline__ void xcd_barrier(const XcdBarrier& b) {
    asm volatile("s_waitcnt vmcnt(0)" ::: "memory");
    __syncthreads();
    if (threadIdx.x == 0) {
        unsigned* bar = b.bar;
        __builtin_amdgcn_s_waitcnt(0);
        unsigned nloc = b.st[0], nx = b.st[1];
        if (nloc == 0u) { xcd_barrier_complete(bar, b.x, nloc, nx); b.st[0] = nloc; b.st[1] = nx; }
        const unsigned old = xb_add(&bar[XB_XSUB(b.x)], 1u);
        const unsigned gen = old / nloc;
        if (old + 1u == (gen + 1u) * nloc) {
            __builtin_amdgcn_fence(__ATOMIC_RELEASE, "agent");
            asm volatile("s_waitcnt vmcnt(0)" ::: "memory");
            const unsigned og = xb_add(&bar[XB_TOP], 1u);
            const unsigned tg = og / nx;
            if (og + 1u == (tg + 1u) * nx) xb_add(&bar[XB_TOPGEN], 1u);
            else XB_SPIN(xb_ld(&bar[XB_TOPGEN]) == tg, bar);
            __builtin_amdgcn_fence(__ATOMIC_ACQUIRE, "agent");
            xb_add(&bar[XB_XGEN(b.x)], 1u);
            asm volatile("s_waitcnt vmcnt(0)" ::: "memory");
        } else {
            XB_SPIN(xb_ld(&bar[XB_XGEN(b.x)]) == gen, bar);
            __builtin_amdgcn_fence(__ATOMIC_ACQUIRE, "agent");
            asm volatile("s_waitcnt vmcnt(0)" ::: "memory");
        }
    }
    __syncthreads();
}

namespace pg8 {
constexpr int BM = 256, BK = 64, HALF = 128, HTB = HALF * BK * 2, STAGE_BYTES = 8 * HTB, NXCD = 8, WGM = 8;
__host__ __device__ __forceinline__ int lds_byte(int r, int c) { const int st = (r >> 4) * 2 + (c >> 5), rr = r & 15, cc = c & 31, ob = rr * 64 + cc * 2; return st * 1024 + (ob ^ (((ob >> 9) & 1) << 5)); }
__host__ __device__ __forceinline__ void stage_rc(int b, int& R, int& C) { const int st = b / 1024, sb = b % 1024, swz = sb ^ (((sb >> 9) & 1) << 5); R = (st >> 1) * 16 + swz / 64; C = (st & 1) * 32 + (swz % 64) / 2; }
__host__ __device__ __forceinline__ int perm32(int rho) { const int n = rho >> 4, i = rho & 15; return 8 * (i >> 2) + 4 * n + (i & 3); }
struct Unit { int pm, pn, ty; };
template <int M_, int N_> struct StaticOrder {
    static constexpr int nM = M_ / BM, nN = N_ / BM, nwg = nM * nN;
    int G, c;
    __device__ __forceinline__ void init(int G_, int c_) { G = G_; c = c_; }
    __device__ __forceinline__ bool next(int i, Unit& u) const {
        const int L = i * G + c; if (L >= nwg) return false;
        int wgid = L; { constexpr int q = nwg / NXCD, r = nwg % NXCD; const int xcd = wgid % NXCD, off = wgid / NXCD; wgid = (xcd < r ? xcd * (q + 1) : r * (q + 1) + (xcd - r) * q) + off; }
        constexpr int nig = WGM * nN; const int gid = wgid / nig, fm = gid * WGM, gsz = (nM - fm) < WGM ? (nM - fm) : WGM;
        u.pm = fm + ((wgid % nig) % gsz); u.pn = (wgid % nig) / gsz; u.ty = 0; return true;
    }
};

template <int LDA, int LDB, int KK, class Epi, class Sched>
__device__ __forceinline__ void gemm_phase(LAS unsigned char* lds, const bf16_t* gA, const bf16_t* gB, const Sched& S, const Epi& E, const bf16_t* gA2 = nullptr, const bf16_t* gB2 = nullptr) {
    int tid_ = threadIdx.x; asm volatile("" : "+v"(tid_));
    const int tid = tid_, wid = __builtin_amdgcn_readfirstlane(tid >> 6), lane = tid & 63, wr = wid >> 2, wc = wid & 3, fr = lane & 15, fq = lane >> 4;
    constexpr int nt = KK / BK;
    unsigned voffA[2], voffB[2];
#pragma unroll
    for (int i = 0; i < 2; ++i) { int R, C; stage_rc(tid * 16 + i * 8192, R, C); const int Rb = Epi::PERM ? ((R & ~31) + perm32(R & 31)) : R;
        voffA[i] = (unsigned)(R * LDA + C) * 2u; voffB[i] = (unsigned)(Rb * LDB + C) * 2u; }
    constexpr size_t kstep = (size_t)(BK * 2);
    constexpr size_t hstepA = (size_t)HALF * LDA * 2, hstepB = (size_t)HALF * LDB * 2;
    constexpr size_t tstepA = 2 * hstepA, tstepB = 2 * hstepB;
    const unsigned ldsw = (unsigned)wid * 1024u;
    const int aoff = lds_byte(wr * 64 + fr, fq * 8), boff = lds_byte(wc * 32 + fr, fq * 8);
#define PG8_SA(b, h) (((b) * 2 + (h)) * HTB)
#define PG8_SB(b, h) ((4 + (b) * 2 + (h)) * HTB)
#define PG8_STAGE(bufoff, gbase, voff) do { _Pragma("unroll") for (int _i = 0; _i < 2; ++_i) \
        __builtin_amdgcn_global_load_lds((const unsigned*)((const char*)(gbase) + (voff)[_i]), (LAS unsigned*)(lds + (bufoff) + ldsw + _i * 8192), 16, 0, 0); } while (0)
#define PG8_LDA(dst, b, h) do { _Pragma("unroll") for (int m = 0; m < 4; ++m) _Pragma("unroll") for (int k = 0; k < 2; ++k) dst[m][k] = *(const LAS bf16x8*)(lds + PG8_SA(b, h) + aoff + m * 2048 + k * 1024); } while (0)
#define PG8_LDB(dst, b, h) do { _Pragma("unroll") for (int n = 0; n < 2; ++n) _Pragma("unroll") for (int k = 0; k < 2; ++k) dst[n][k] = *(const LAS bf16x8*)(lds + PG8_SB(b, h) + boff + n * 2048 + k * 1024); } while (0)
#define PG8_MMA(ai, bj, At, Bt) do { __builtin_amdgcn_s_setprio(1); _Pragma("unroll") for (int m = 0; m < 4; ++m) _Pragma("unroll") for (int n = 0; n < 2; ++n) _Pragma("unroll") for (int k = 0; k < 2; ++k) \
        acc[ai][bj][m][n] = __builtin_amdgcn_mfma_f32_16x16x32_bf16(Bt[n][k], At[m][k], acc[ai][bj][m][n], 0, 0, 0); __builtin_amdgcn_s_setprio(0); } while (0)
#define PG8_WAIT_V(n) asm volatile("s_waitcnt vmcnt(" #n ")" ::: "memory")
#define PG8_WAIT_L(n) asm volatile("s_waitcnt lgkmcnt(" #n ")" ::: "memory")
#define PG8_BAR __builtin_amdgcn_s_barrier()
#define PG8_SCHED __builtin_amdgcn_sched_barrier(0)
    Unit cur, nxt; int ui = 0;
    if (!S.next(0, cur)) return;
    LAS float* rtab = (LAS float*)(lds + RTAB_OFF);
    { const typename Epi::Pre p0 = E.prep_load(cur, tid); E.prep_store(p0, rtab, tid); }
    f32x4 acc[2][2][4][2];
#pragma unroll
    for (int a = 0; a < 2; ++a)
#pragma unroll
        for (int b = 0; b < 2; ++b)
#pragma unroll
            for (int m = 0; m < 4; ++m)
#pragma unroll
                for (int n = 0; n < 2; ++n) acc[a][b][m][n] = (f32x4){0.f, 0.f, 0.f, 0.f};
    bf16x8 At[4][2], B0[2][2], B1[2][2];
    const char* cA = (const char*)(cur.ty ? gA2 : gA) + (size_t)cur.pm * tstepA; const char* cB = (const char*)(cur.ty ? gB2 : gB) + (size_t)cur.pn * tstepB;
    PG8_STAGE(PG8_SB(0, 0), cB, voffB); PG8_STAGE(PG8_SB(0, 1), cB + hstepB, voffB); PG8_STAGE(PG8_SA(0, 0), cA, voffA); PG8_STAGE(PG8_SA(0, 1), cA + hstepA, voffA);
    if (wr == 1) PG8_BAR;
    PG8_WAIT_V(2); PG8_BAR;
    PG8_STAGE(PG8_SB(1, 0), cB + kstep, voffB); PG8_STAGE(PG8_SA(1, 0), cA + kstep, voffA); PG8_STAGE(PG8_SB(1, 1), cB + hstepB + kstep, voffB);
    PG8_WAIT_V(6); PG8_BAR;
    for (;;) {
        const bool has_next = S.next(ui + 1, nxt);
        const char* nA = has_next ? (const char*)(nxt.ty ? gA2 : gA) + (size_t)nxt.pm * tstepA : cA; const char* nB = has_next ? (const char*)(nxt.ty ? gB2 : gB) + (size_t)nxt.pn * tstepB : cB;
        for (int t = 0; t < nt; t += 2) {
            const bool last = (t == nt - 2);
            const char* a1 = cA + (size_t)(t + 1) * kstep;
            const char* a2 = last ? nA : cA + (size_t)(t + 2) * kstep; const char* b2 = last ? nB : cB + (size_t)(t + 2) * kstep;
            const char* a3 = a2 + kstep; const char* b3 = b2 + kstep;
            PG8_LDB(B0, 0, 0); PG8_LDB(B1, 0, 1); PG8_SCHED; PG8_LDA(At, 0, 0); PG8_STAGE(PG8_SA(1, 1), a1 + hstepA, voffA);
            PG8_WAIT_V(8); PG8_WAIT_L(0); PG8_BAR; PG8_MMA(0, 0, At, B0); PG8_MMA(0, 1, At, B1); PG8_BAR; PG8_SCHED;
            PG8_LDA(At, 0, 1); PG8_STAGE(PG8_SB(0, 0), b2, voffB); PG8_STAGE(PG8_SB(0, 1), b2 + hstepB, voffB); PG8_STAGE(PG8_SA(0, 0), a2, voffA);
            PG8_WAIT_V(8); PG8_WAIT_L(0); PG8_BAR; PG8_MMA(1, 0, At, B0); PG8_MMA(1, 1, At, B1); PG8_BAR; PG8_SCHED;
            PG8_LDB(B0, 1, 0); PG8_LDB(B1, 1, 1); PG8_SCHED; PG8_LDA(At, 1, 0); PG8_STAGE(PG8_SA(0, 1), a2 + hstepA, voffA);
            PG8_WAIT_V(8); PG8_WAIT_L(0); PG8_BAR; PG8_MMA(0, 0, At, B0); PG8_MMA(0, 1, At, B1); PG8_BAR; PG8_SCHED;
            PG8_LDA(At, 1, 1); PG8_STAGE(PG8_SB(1, 0), b3, voffB); PG8_STAGE(PG8_SB(1, 1), b3 + hstepB, voffB); PG8_STAGE(PG8_SA(1, 0), a3, voffA);
            PG8_WAIT_V(8); PG8_WAIT_L(0); PG8_BAR; PG8_MMA(1, 0, At, B0); PG8_MMA(1, 1, At, B1); PG8_BAR; PG8_SCHED;
        }
        if (wr == 0) PG8_BAR;
        typename Epi::Pre pre; if (has_next) pre = E.prep_load(nxt, tid);
        if constexpr (Epi::FINAL) E.final(acc, cur, wr, wc, fr, fq, rtab, tid, wid, lane); else E(acc, cur, wr, wc, fr, fq, rtab + (ui & 1) * 256);
        if (!has_next) break;
#pragma unroll
        for (int a = 0; a < 2; ++a)
#pragma unroll
            for (int b = 0; b < 2; ++b)
#pragma unroll
                for (int m = 0; m < 4; ++m)
#pragma unroll
                    for (int n = 0; n < 2; ++n) acc[a][b][m][n] = (f32x4){0.f, 0.f, 0.f, 0.f};
        cur = nxt; cA = nA; cB = nB; ++ui;
        E.prep_store(pre, rtab + (ui & 1) * 256, tid);
        if (wr == 1) PG8_BAR;
    }
    PG8_WAIT_V(0);
    PG8_BAR;
#undef PG8_SA
#undef PG8_SB
#undef PG8_STAGE
#undef PG8_LDA
#undef PG8_LDB
#undef PG8_MMA
#undef PG8_WAIT_V
#undef PG8_WAIT_L
#undef PG8_BAR
#undef PG8_SCHED
}
}

__device__ __forceinline__ float lg_f(int h) { return __builtin_amdgcn_logf(1.0f - __builtin_amdgcn_exp2f(-5.0f - (float)h)); }
__device__ __forceinline__ float lg_b(int h) { return __builtin_amdgcn_logf(1.0f - __builtin_amdgcn_exp2f(-5.5f - (float)h)); }
typedef f32x4 AccT[2][2][4][2];
__device__ __forceinline__ float row_scale(const float* ssp, int r) {
    const f32x4* p = (const f32x4*)(ssp + (size_t)r * 16); const f32x4 a = p[0], b = p[1], c = p[2], d = p[3];
    const float s = ((a.x + a.y) + (a.z + a.w)) + ((b.x + b.y) + (b.z + b.w)) + ((c.x + c.y) + (c.z + c.w)) + ((d.x + d.y) + (d.z + d.w));
    return __builtin_amdgcn_rsqf(s * (1.0f / 1024.0f) + EPS);
}
struct PreNone {};
struct PreSS { f32x4 a, b, c, d; };
__device__ __forceinline__ PreSS ss_load(const float* ssp, int r0, int tid) { PreSS p; if (tid < 256) { const f32x4* q = (const f32x4*)(ssp + (size_t)(r0 + tid) * 16); p.a = q[0]; p.b = q[1]; p.c = q[2]; p.d = q[3]; } else { p.a = p.b = p.c = p.d = (f32x4){0.f, 0.f, 0.f, 0.f}; } return p; }
__device__ __forceinline__ void ss_store(const PreSS& p, LAS float* tab, int tid) {
    const float s = ((p.a.x + p.a.y) + (p.a.z + p.a.w)) + ((p.b.x + p.b.y) + (p.b.z + p.b.w)) + ((p.c.x + p.c.y) + (p.c.z + p.c.w)) + ((p.d.x + p.d.y) + (p.d.z + p.d.w));
    if (tid < 256) tab[tid] = __builtin_amdgcn_rsqf(s * (1.0f / 1024.0f) + EPS); }
__device__ __forceinline__ u32x4 pack8(const f32x4 a, const f32x4 b) { u32x4 w; w.x = cvt_pk_bf16(a.x, a.y); w.y = cvt_pk_bf16(a.z, a.w); w.z = cvt_pk_bf16(b.x, b.y); w.w = cvt_pk_bf16(b.z, b.w); return w; }
#define EPI_FENCE() asm volatile("" ::: "memory")
__device__ __forceinline__ void store_wt(void* p, u32x4 v) { asm volatile("global_store_dwordx4 %0, %1, off sc1\n\ts_nop 1" :: "v"(p), "v"(v) : "memory"); }

struct EpiConvIn { static constexpr bool FINAL = false, PERM = true; bf16_t* U; bf16_t* GB; const float* ssp;
    typedef PreSS Pre;
    __device__ __forceinline__ Pre prep_load(const pg8::Unit& u, int tid) const { return ss_load(ssp, u.pm * 256, tid); }
    __device__ __forceinline__ void prep_store(const Pre& p, LAS float* tab, int tid) const { ss_store(p, tab, tid); }
    __device__ __forceinline__ void operator()(const AccT& acc, const pg8::Unit& u, int wr, int wc, int fr, int fq, const LAS float* tab) const {
        const int rl0 = wr * 64 + fr;
#pragma unroll
        for (int ai = 0; ai < 2; ++ai)
#pragma unroll
            for (int m = 0; m < 4; ++m) { const int rl = rl0 + ai * 128 + m * 16, r = u.pm * 256 + rl; const float rs = tab[rl];
                if (u.pn < 8) { const float r2 = rs * rs;
                    const f32x4 u0 = acc[ai][0][m][0] * acc[ai][1][m][0] * r2, u1 = acc[ai][0][m][1] * acc[ai][1][m][1] * r2;
                    *(u32x4*)(U + (size_t)r * D + 128 * u.pn + 32 * wc + 8 * fq) = pack8(u0, u1);
                } else {
#pragma unroll
                    for (int bj = 0; bj < 2; ++bj) *(u32x4*)(GB + (size_t)r * D + 256 * (u.pn - 8) + 128 * bj + 32 * wc + 8 * fq) = pack8(acc[ai][bj][m][0] * rs, acc[ai][bj][m][1] * rs);
                } }
    }
};
struct EpiRes { static constexpr bool FINAL = false, PERM = false; const float* Xin; bf16_t* XB; float* ssp;
    typedef PreNone Pre;
    __device__ __forceinline__ Pre prep_load(const pg8::Unit&, int) const { return Pre{}; }
    __device__ __forceinline__ void prep_store(const Pre&, LAS float*, int) const {}
    __device__ __forceinline__ void operator()(const AccT& acc, const pg8::Unit& u, int wr, int wc, int fr, int fq, const LAS float*) const {
        const int row0 = u.pm * 256 + wr * 64 + fr, col0 = u.pn * 256 + wc * 32 + 4 * fq;
#pragma unroll
        for (int ai = 0; ai < 2; ++ai)
            {
                f32x4 xr[4][2][2];
#pragma unroll
                for (int mm = 0; mm < 4; ++mm)
#pragma unroll
                    for (int bj = 0; bj < 2; ++bj)
#pragma unroll
                        for (int n = 0; n < 2; ++n) { const size_t o = (size_t)(row0 + ai * 128 + mm * 16) * D + col0 + bj * 128 + n * 16;
                            if (Xin) xr[mm][bj][n] = __builtin_nontemporal_load((const f32x4*)(Xin + o));
                            else { const u32x2 w = *(const u32x2*)(XB + o); xr[mm][bj][n] = (f32x4){bf_lo(w.x), bf_hi(w.x), bf_lo(w.y), bf_hi(w.y)}; } }
                EPI_FENCE();
#pragma unroll
                for (int mm = 0; mm < 4; ++mm) { const int m = mm, r = row0 + ai * 128 + m * 16; float ss = 0.f;
#pragma unroll
                    for (int bj = 0; bj < 2; ++bj)
#pragma unroll
                        for (int n = 0; n < 2; ++n) { const size_t o = (size_t)r * D + col0 + bj * 128 + n * 16;
                            const f32x4 x = xr[mm][bj][n] + acc[ai][bj][m][n];
                            ss += (x.x * x.x + x.y * x.y) + (x.z * x.z + x.w * x.w);
                            u32x2 w; w.x = cvt_pk_bf16(x.x, x.y); w.y = cvt_pk_bf16(x.z, x.w); *(u32x2*)(XB + o) = w; }
                    { const int ln = fr + 16 * fq; ss += shx(ss, 16, ln); ss += shx(ss, 32, ln); }
                    if (fq == 0) ssp[(size_t)r * 16 + 4 * u.pn + wc] = ss; }
                EPI_FENCE(); }
    }
};
struct EpiFinal { static constexpr bool FINAL = true, PERM = false; const bf16_t* XB; float* out; float* ssp; const float* gfin; unsigned* cnt;
    typedef PreNone Pre;
    __device__ __forceinline__ Pre prep_load(const pg8::Unit&, int) const { return Pre{}; }
    __device__ __forceinline__ void prep_store(const Pre&, LAS float*, int) const {}
    __device__ __forceinline__ void final(AccT& acc, const pg8::Unit& u, int wr, int wc, int fr, int fq, LAS float* tab, int tid, int wid, int lane) const {
        const int row0 = u.pm * 256 + wr * 64 + fr, col0 = u.pn * 256 + wc * 32 + 4 * fq;
#pragma unroll
        for (int ai = 0; ai < 2; ++ai)
            {
                f32x4 xr[4][2][2];
#pragma unroll
                for (int mm = 0; mm < 4; ++mm)
#pragma unroll
                    for (int bj = 0; bj < 2; ++bj)
#pragma unroll
                        for (int n = 0; n < 2; ++n) { const u32x2 w = *(const u32x2*)(XB + (size_t)(row0 + ai * 128 + mm * 16) * D + col0 + bj * 128 + n * 16); xr[mm][bj][n] = (f32x4){bf_lo(w.x), bf_hi(w.x), bf_lo(w.y), bf_hi(w.y)}; }
                EPI_FENCE();
#pragma unroll
                for (int mm = 0; mm < 4; ++mm) { const int m = mm, r = row0 + ai * 128 + m * 16; float ss = 0.f;
#pragma unroll
                    for (int bj = 0; bj < 2; ++bj)
#pragma unroll
                        for (int n = 0; n < 2; ++n) { const f32x4 x = xr[mm][bj][n] + acc[ai][bj][m][n]; acc[ai][bj][m][n] = x; ss += (x.x * x.x + x.y * x.y) + (x.z * x.z + x.w * x.w); }
                    { const int ln = fr + 16 * fq; ss += shx(ss, 16, ln); ss += shx(ss, 32, ln); }
                    if (fq == 0) ssp[(size_t)r * 16 + 4 * u.pn + wc] = ss; }
                EPI_FENCE(); }
        asm volatile("s_waitcnt vmcnt(0)" ::: "memory");
        __builtin_amdgcn_s_barrier();
        asm volatile("" ::: "memory");
        if (wid == 0) {
            unsigned* c = cnt + 64 * u.pm;
            __builtin_amdgcn_fence(__ATOMIC_RELEASE, "agent");
            asm volatile("s_waitcnt vmcnt(0)" ::: "memory");
            if (lane == 0) (void)__hip_atomic_fetch_add(c, 1u, __ATOMIC_RELAXED, __HIP_MEMORY_SCOPE_AGENT);
            unsigned sp = 0;
            while ((unsigned)__builtin_amdgcn_readfirstlane(__hip_atomic_load(c, __ATOMIC_RELAXED, __HIP_MEMORY_SCOPE_AGENT)) < 4u) { __builtin_amdgcn_s_sleep(2); if (++sp > (1u << 22)) break; }
            __builtin_amdgcn_fence(__ATOMIC_ACQUIRE, "agent");
            asm volatile("s_waitcnt vmcnt(0)" ::: "memory");
        }
        __builtin_amdgcn_s_barrier();
        asm volatile("" ::: "memory");
        if (tid < 256) tab[tid] = row_scale(ssp, u.pm * 256 + tid);
        f32x4 gv[2][2];
#pragma unroll
        for (int bj = 0; bj < 2; ++bj)
#pragma unroll
            for (int n = 0; n < 2; ++n) gv[bj][n] = *(const f32x4*)(gfin + col0 + bj * 128 + n * 16);
        asm volatile("s_waitcnt lgkmcnt(0)" ::: "memory");
        __builtin_amdgcn_s_barrier();
        asm volatile("" ::: "memory");
#pragma unroll
        for (int ai = 0; ai < 2; ++ai)
#pragma unroll
            for (int m = 0; m < 4; ++m) { const int rl = wr * 64 + fr + ai * 128 + m * 16; const float rs = tab[rl];
#pragma unroll
                for (int bj = 0; bj < 2; ++bj)
#pragma unroll
                    for (int n = 0; n < 2; ++n) __builtin_nontemporal_store(acc[ai][bj][m][n] * rs * gv[bj][n], (f32x4*)(out + (size_t)(u.pm * 256 + rl) * D + col0 + bj * 128 + n * 16)); }
    }
};
struct EpiUp { static constexpr bool FINAL = false, PERM = true; bf16_t* H; const float* ssp;
    typedef PreSS Pre;
    __device__ __forceinline__ Pre prep_load(const pg8::Unit& u, int tid) const { return ss_load(ssp, u.pm * 256, tid); }
    __device__ __forceinline__ void prep_store(const Pre& p, LAS float* tab, int tid) const { ss_store(p, tab, tid); }
    __device__ __forceinline__ void operator()(const AccT& acc, const pg8::Unit& u, int wr, int wc, int fr, int fq, const LAS float* tab) const {
        const int rl0 = wr * 64 + fr;
#pragma unroll
        for (int ai = 0; ai < 2; ++ai)
#pragma unroll
            for (int m = 0; m < 4; ++m) { const int rl = rl0 + ai * 128 + m * 16, r = u.pm * 256 + rl; const float rs = tab[rl];
#pragma unroll
                for (int bj = 0; bj < 2; ++bj) { f32x4 a = acc[ai][bj][m][0] * rs, b = acc[ai][bj][m][1] * rs;
                    a = __builtin_elementwise_max(a, (f32x4){0.f, 0.f, 0.f, 0.f}); b = __builtin_elementwise_max(b, (f32x4){0.f, 0.f, 0.f, 0.f});
                    store_wt(H + (size_t)r * FF + 256 * u.pn + 128 * bj + 32 * wc + 8 * fq, pack8(a * a, b * b)); } }
    }
};
struct EpiQKG { static constexpr bool FINAL = false, PERM = true; bf16_t* Q; bf16_t* Kb; bf16_t* KF; bf16_t* KW; bf16_t* A3; const float* ssp; const float* rope; int smask;
    typedef PreSS Pre;
    __device__ __forceinline__ Pre prep_load(const pg8::Unit& u, int tid) const { return ss_load(ssp, u.pm * 256, tid); }
    __device__ __forceinline__ void prep_store(const Pre& p, LAS float* tab, int tid) const { ss_store(p, tab, tid); }
    __device__ __forceinline__ void operator()(const AccT& acc, const pg8::Unit& u, int wr, int wc, int fr, int fq, const LAS float* tab) const {
        const int rl0 = wr * 64 + fr;
#pragma unroll
        for (int ai = 0; ai < 2; ++ai)
#pragma unroll
            for (int m = 0; m < 4; ++m) { const int rl = rl0 + ai * 128 + m * 16, r = u.pm * 256 + rl; const float rs = tab[rl];
                if (u.pn < 8) {
                    const int c = 32 * wc + 8 * fq; const float sc = (u.pn < 4) ? rs * 0.0625f : rs;
                    const f32x4* tp = (const f32x4*)(rope + ((size_t)(r & smask) * 128 + c) * 2);
                    const f32x4 t0 = tp[0], t1 = tp[1], t2 = tp[2], t3 = tp[3];
                    const f32x4 x1a = acc[ai][0][m][0] * sc, x1b = acc[ai][0][m][1] * sc, x2a = acc[ai][1][m][0] * sc, x2b = acc[ai][1][m][1] * sc;
                    const f32x4 ca = {t0.x, t0.z, t1.x, t1.z}, sa = {t0.y, t0.w, t1.y, t1.w}, cb = {t2.x, t2.z, t3.x, t3.z}, sb = {t2.y, t2.w, t3.y, t3.w};
                    const f32x4 o1a = x1a * ca - x2a * sa, o1b = x1b * cb - x2b * sb, o2a = x1a * sa + x2a * ca, o2b = x1b * sb + x2b * cb;
                    bf16_t* dst = ((u.pn < 4) ? Q : Kb) + (size_t)r * 1024 + 256 * (u.pn & 3) + c;
                    *(u32x4*)(dst) = pack8(o1a, o1b); *(u32x4*)(dst + 128) = pack8(o2a, o2b);
                    if (u.pn >= 4) { const int hh = u.pn & 3, tt = r & 511; const size_t ko = (size_t)r * 1024 + 256 * hh + c;
                        const float wf = __builtin_amdgcn_exp2f(lg_f(hh) * (float)(511 - tt)), wb = __builtin_amdgcn_exp2f(lg_b(hh) * (float)tt);
                        *(u32x4*)(KF + ko) = pack8(o1a * wf, o1b * wf); *(u32x4*)(KF + ko + 128) = pack8(o2a * wf, o2b * wf);
                        *(u32x4*)(KW + ko) = pack8(o1a * wb, o1b * wb); *(u32x4*)(KW + ko + 128) = pack8(o2a * wb, o2b * wb); }
                    if (m == 3) EPI_FENCE();
                } else {
#pragma unroll
                    for (int bj = 0; bj < 2; ++bj) { f32x4 a = acc[ai][bj][m][0] * rs, b = acc[ai][bj][m][1] * rs;
#pragma unroll
                        for (int i = 0; i < 4; ++i) { a[i] = a[i] * __builtin_amdgcn_rcpf(1.0f + __builtin_amdgcn_exp2f(-1.44269504f * a[i])); b[i] = b[i] * __builtin_amdgcn_rcpf(1.0f + __builtin_amdgcn_exp2f(-1.44269504f * b[i])); }
                        *(u32x4*)(A3 + (size_t)r * DVW + 256 * (u.pn - 8) + 128 * bj + 32 * wc + 8 * fq) = pack8(a, b); }
                } }
    }
};
struct EpiVT { static constexpr bool FINAL = false, PERM = true; bf16_t* VT; const float* ssp;
    typedef PreSS Pre;
    __device__ __forceinline__ Pre prep_load(const pg8::Unit& u, int tid) const { return ss_load(ssp, u.pn * 256, tid); }
    __device__ __forceinline__ void prep_store(const Pre& p, LAS float* tab, int tid) const { ss_store(p, tab, tid); }
    __device__ __forceinline__ void operator()(const AccT& acc, const pg8::Unit& u, int wr, int wc, int fr, int fq, const LAS float* tab) const {
        const int row0 = u.pm * 256 + wr * 64 + fr, cl0 = 32 * wc + 8 * fq, col0 = u.pn * 256 + cl0;
        f32x4 s[2][2];
#pragma unroll
        for (int bj = 0; bj < 2; ++bj)
#pragma unroll
            for (int n = 0; n < 2; ++n) s[bj][n] = *(const LAS f32x4*)(tab + cl0 + 128 * bj + 4 * n);
#pragma unroll
        for (int ai = 0; ai < 2; ++ai)
#pragma unroll
            for (int m = 0; m < 4; ++m) { const int r = row0 + ai * 128 + m * 16;
#pragma unroll
                for (int bj = 0; bj < 2; ++bj) *(u32x4*)(VT + (size_t)r * SLAB + col0 + 128 * bj) = pack8(acc[ai][bj][m][0] * s[bj][0], acc[ai][bj][m][1] * s[bj][1]); }
    }
};

struct QkvOrder { pg8::StaticOrder<SLAB, 4096> s0; pg8::StaticOrder<DVW, SLAB> s1;
    __device__ __forceinline__ void init(int G_, int c_) { s0.init(G_, c_); s1.init(G_, c_); }
    __device__ __forceinline__ bool next(int i, pg8::Unit& u) const { if (i < 2) return s0.next(i, u); const bool ok = s1.next(i - 2, u); u.ty = 1; return ok; }
};
struct EpiQKVG { static constexpr bool FINAL = false, PERM = true; EpiQKG a; EpiVT b;
    typedef PreSS Pre;
    __device__ __forceinline__ Pre prep_load(const pg8::Unit& u, int tid) const { return u.ty ? b.prep_load(u, tid) : a.prep_load(u, tid); }
    __device__ __forceinline__ void prep_store(const Pre& p, LAS float* tab, int tid) const { ss_store(p, tab, tid); }
    __device__ __forceinline__ void operator()(const AccT& acc, const pg8::Unit& u, int wr, int wc, int fr, int fq, const LAS float* tab) const { if (u.ty) b(acc, u, wr, wc, fr, fq, tab); else a(acc, u, wr, wc, fr, fq, tab); }
};

__device__ __forceinline__ float wave_sum(float v, int lane) {
#pragma unroll
    for (int o = 1; o < 64; o <<= 1) v += shx(v, o, lane);
    return v;
}
__device__ __forceinline__ void transpose_item(const float* W, int K, int N, const float* gain, bf16_t* WT, int drow0, int scol0, int k0, LAS float* scr, int lane) {
    f32x4 v[8];
#pragma unroll
    for (int i = 0; i < 8; ++i) { const int kk = 8 * i + (lane >> 3); v[i] = __builtin_nontemporal_load((const f32x4*)(W + (size_t)(k0 + kk) * N + scol0 + 4 * (lane & 7))); }
#pragma unroll
    for (int i = 0; i < 8; ++i) { const int kk = 8 * i + (lane >> 3); const float gv = gain ? gain[k0 + kk] : 1.0f; LAS float* d = scr + kk * 33 + 4 * (lane & 7);
        d[0] = v[i].x * gv; d[1] = v[i].y * gv; d[2] = v[i].z * gv; d[3] = v[i].w * gv; }
    asm volatile("s_waitcnt lgkmcnt(0)" ::: "memory");
    const int c = lane & 7;
#pragma unroll
    for (int j = 0; j < 4; ++j) { const int n = (lane >> 3) + 8 * j; const LAS float* s = scr + (8 * c) * 33 + n;
        u32x4 o; o.x = cvt_pk_bf16(s[0 * 33], s[1 * 33]); o.y = cvt_pk_bf16(s[2 * 33], s[3 * 33]); o.z = cvt_pk_bf16(s[4 * 33], s[5 * 33]); o.w = cvt_pk_bf16(s[6 * 33], s[7 * 33]);
        *(u32x4*)(WT + (size_t)(drow0 + n) * K + k0 + 8 * c) = o; }
    asm volatile("s_waitcnt lgkmcnt(0)" ::: "memory");
}
__device__ __forceinline__ void xb_prep(const float* x, bf16_t* XB, float* ssp, int gw, int ngw, int lane, int nrows = MG) {
    for (int r = gw; r < nrows; r += 2 * ngw) {
        const int r2 = r + ngw;
        const f32x4* xa = (const f32x4*)(x + (size_t)r * D) + lane; const f32x4* xb = (const f32x4*)(x + (size_t)r2 * D) + lane;
        f32x4 va[4], vb[4];
#pragma unroll
        for (int j = 0; j < 4; ++j) { va[j] = __builtin_nontemporal_load(xa + 64 * j); vb[j] = __builtin_nontemporal_load(xb + 64 * j); }
        unsigned long long* oa = (unsigned long long*)(XB + (size_t)r * D) + lane; unsigned long long* ob = (unsigned long long*)(XB + (size_t)r2 * D) + lane;
        float sa = 0.f, sb2 = 0.f;
#pragma unroll
        for (int j = 0; j < 4; ++j) { const f32x4 v = va[j], w = vb[j];
            sa += (v.x * v.x + v.y * v.y) + (v.z * v.z + v.w * v.w); sb2 += (w.x * w.x + w.y * w.y) + (w.z * w.z + w.w * w.w);
            oa[64 * j] = (unsigned long long)cvt_pk_bf16(v.x, v.y) | ((unsigned long long)cvt_pk_bf16(v.z, v.w) << 32);
            ob[64 * j] = (unsigned long long)cvt_pk_bf16(w.x, w.y) | ((unsigned long long)cvt_pk_bf16(w.z, w.w) << 32); }
#pragma unroll
        for (int o = 1; o < 64; o <<= 1) { sa += shx(sa, o, lane); sb2 += shx(sb2, o, lane); }
        if (lane < 16) { ssp[(size_t)r * 16 + lane] = (lane == 0) ? sa : 0.f; ssp[(size_t)r2 * 16 + lane] = (lane == 0) ? sb2 : 0.f; }
    }
}
__device__ __forceinline__ void rope_entry(float* rope, int idx) {
    const int pos = idx >> 7, c = idx & 127;
    const float inv = (float)exp2(-(double)c * (13.287712379549449 / 128.0));
    const float angf = (float)pos * inv;
    const double ang = (double)angf;
    const double kq = rint(ang * 0.63661977236758134308);
    double r = fma(-kq, 1.57079632679489655800e+00, ang); r = fma(-kq, 6.12323399573676603587e-17, r);
    const double r2 = r * r;
    double sn = 1.0 / 6227020800.0; sn = fma(sn, r2, -1.0 / 39916800.0); sn = fma(sn, r2, 1.0 / 362880.0); sn = fma(sn, r2, -1.0 / 5040.0); sn = fma(sn, r2, 1.0 / 120.0); sn = fma(sn, r2, -1.0 / 6.0); sn = fma(sn * r2, r, r);
    double cs = 1.0 / 479001600.0; cs = fma(cs, r2, -1.0 / 3628800.0); cs = fma(cs, r2, 1.0 / 40320.0); cs = fma(cs, r2, -1.0 / 720.0); cs = fma(cs, r2, 1.0 / 24.0); cs = fma(cs, r2, -0.5); cs = fma(cs, r2, 1.0);
    const int q = ((int)kq) & 3;
    const double c0 = (q == 0) ? cs : (q == 1) ? -sn : (q == 2) ? -cs : sn;
    const double s0 = (q == 0) ? sn : (q == 1) ? cs : (q == 2) ? -sn : -cs;
    *(f32x2*)(rope + (size_t)idx * 2) = (f32x2){(float)c0, (float)s0};
}

constexpr int BLK = 512;
__device__ __forceinline__ unsigned offb(unsigned row, unsigned ch) { return 256u * row + 16u * (ch ^ (((row & 3u) << 2) | ((row >> 2) & 3u))); }
__device__ __forceinline__ bf16x8 scale8s(bf16x8 v, float w) {
    const u32x4 x = __builtin_bit_cast(u32x4, v); u32x4 o;
    o.x = cvt_pk_bf16(bf_lo(x.x) * w, bf_hi(x.x) * w); o.y = cvt_pk_bf16(bf_lo(x.y) * w, bf_hi(x.y) * w);
    o.z = cvt_pk_bf16(bf_lo(x.z) * w, bf_hi(x.z) * w); o.w = cvt_pk_bf16(bf_lo(x.w) * w, bf_hi(x.w) * w);
    return __builtin_bit_cast(bf16x8, o);
}

__device__ __forceinline__ void chain_phase(LAS unsigned char* lds, const bf16_t* KF, const bf16_t* KW, const bf16_t* VT, bf16_t* ST, int S, int nseq) {
    int tid_ = threadIdx.x; asm volatile("" : "+v"(tid_));
    const int tid = tid_, wid = __builtin_amdgcn_readfirstlane(tid >> 6), lane = tid & 63, fr = lane & 15, fq = lane >> 4, wa = wid >> 1, wb = wid & 1;
    const unsigned ldsb = (unsigned)(size_t)lds;
    const int fragoff = (fr * 64 + fq * 16) ^ (((fr >> 3) & 1) << 5);
    const int sb = lane * 16, swz = sb ^ (((sb >> 9) & 1) << 5), dR = swz >> 6, dC = (swz & 63) >> 1;
    const int N = S / BLK, nst = (S - BLK) / 64;
    unsigned tra[2][2];
    { const unsigned q = (lane & 15) >> 2, p = lane & 3;
#pragma unroll
      for (int i = 0; i < 2; ++i)
#pragma unroll
          for (int t = 0; t < 2; ++t) tra[i][t] = offb(8u * fq + 4u * t + q, 2u * (2 * wa + i) + (p >> 1)) + 8u * (p & 1); }
    const int sub = blockIdx.x >> 3, pr = (int)(blockIdx.x & 7) + 8 * (sub >> 4);
    if (sub < 32 && pr < nseq * 4) {
        const int s4 = sub & 15, dvq = s4 & 3, dkh = (s4 >> 2) & 1, dir = s4 >> 3, h = pr & 3, sq = pr >> 2;
        const int seq0 = sq * S;
        const float lg = dir ? lg_b(h) : lg_f(h);
        const float d512 = __builtin_amdgcn_exp2f(lg * 512.0f);
        f32x4 acc[2][4];
#pragma unroll
        for (int i = 0; i < 2; ++i)
#pragma unroll
            for (int j = 0; j < 4; ++j) acc[i][j] = (f32x4){0.f, 0.f, 0.f, 0.f};
        const bf16_t* kg[2]; const bf16_t* vg[2];
#pragma unroll
        for (int jj = 0; jj < 2; ++jj) { const int p = 2 * wid + jj, row = 4 * (p & 7) + (lane >> 4), ch = (lane & 15) ^ (((row & 3) << 2) | ((row >> 2) & 3));
            kg[jj] = (dir ? KW : KF) + (size_t)(seq0 + 32 * (p >> 3) + row) * 1024 + 256 * h + 128 * dkh + 8 * ch;
            vg[jj] = VT + (size_t)(512 * h + 128 * dvq + 16 * (p >> 1) + dR) * SLAB + seq0 + 32 * (p & 1) + dC; }
        bf16_t* stbase = ST + ((size_t)(((sq * 4 + h) * 2 + dir) * (N - 1)) << 17) + (size_t)(128 * dvq + 64 * wb + fr) * 256 + 128 * dkh + 32 * wa + 4 * fq;
#define CH_DMA(u_) do { const int _u = (u_) < nst ? (u_) : nst - 1; const int _tb = dir ? (S - 64 * (_u + 1)) : 64 * _u; LAS unsigned char* _d = lds + ((u_) & 3) * 32768; \
        __builtin_amdgcn_global_load_lds((const unsigned*)(kg[0] + (size_t)_tb * 1024), (LAS unsigned*)(_d + (2 * wid) * 1024), 16, 0, 0); \
        __builtin_amdgcn_global_load_lds((const unsigned*)(kg[1] + (size_t)_tb * 1024), (LAS unsigned*)(_d + (2 * wid + 1) * 1024), 16, 0, 0); \
        __builtin_amdgcn_global_load_lds((const unsigned*)(vg[0] + _tb), (LAS unsigned*)(_d + 16384 + (2 * wid) * 1024), 16, 0, 0); \
        __builtin_amdgcn_global_load_lds((const unsigned*)(vg[1] + _tb), (LAS unsigned*)(_d + 16384 + (2 * wid + 1) * 1024), 16, 0, 0); } while (0)
        CH_DMA(0); CH_DMA(1); CH_DMA(2);
#pragma unroll 1
        for (int u = 0; u < nst; ++u) {
            asm volatile("s_waitcnt vmcnt(8)" ::: "memory");
            __builtin_amdgcn_s_barrier();
            asm volatile("" ::: "memory");
            CH_DMA(u + 3);
            LAS unsigned char* stg = lds + (u & 3) * 32768;
            {
                const unsigned kimg = ldsb + (u & 3) * 32768;
                bf16x8 v0[4], v1[4];
#pragma unroll
                for (int j = 0; j < 4; ++j) { v0[j] = *(const LAS bf16x8*)(stg + 16384 + ((4 * wb + j) * 2 + 0) * 1024 + fragoff); v1[j] = *(const LAS bf16x8*)(stg + 16384 + ((4 * wb + j) * 2 + 1) * 1024 + fragoff); }
                u32x2 a00, a01, a10, a11, b00, b01, b10, b11;
                asm volatile("ds_read_b64_tr_b16 %0, %8\n\tds_read_b64_tr_b16 %1, %9\n\tds_read_b64_tr_b16 %2, %10\n\tds_read_b64_tr_b16 %3, %11\n\t"
                             "ds_read_b64_tr_b16 %4, %8 offset:8192\n\tds_read_b64_tr_b16 %5, %9 offset:8192\n\tds_read_b64_tr_b16 %6, %10 offset:8192\n\tds_read_b64_tr_b16 %7, %11 offset:8192\n\ts_waitcnt lgkmcnt(0)"
                             : "=&v"(a00), "=&v"(a01), "=&v"(a10), "=&v"(a11), "=&v"(b00), "=&v"(b01), "=&v"(b10), "=&v"(b11)
                             : "v"(kimg + tra[0][0]), "v"(kimg + tra[0][1]), "v"(kimg + tra[1][0]), "v"(kimg + tra[1][1]) : "memory");
                const bf16x8 A0 = __builtin_bit_cast(bf16x8, (u32x4){a00.x, a00.y, a01.x, a01.y}), A1 = __builtin_bit_cast(bf16x8, (u32x4){a10.x, a10.y, a11.x, a11.y});
                const bf16x8 B0 = __builtin_bit_cast(bf16x8, (u32x4){b00.x, b00.y, b01.x, b01.y}), B1 = __builtin_bit_cast(bf16x8, (u32x4){b10.x, b10.y, b11.x, b11.y});
                __builtin_amdgcn_s_setprio(1);
#pragma unroll
                for (int j = 0; j < 4; ++j) { acc[0][j] = __builtin_amdgcn_mfma_f32_16x16x32_bf16(A0, v0[j], acc[0][j], 0, 0, 0); acc[1][j] = __builtin_amdgcn_mfma_f32_16x16x32_bf16(A1, v0[j], acc[1][j], 0, 0, 0); }
#pragma unroll
                for (int j = 0; j < 4; ++j) { acc[0][j] = __builtin_amdgcn_mfma_f32_16x16x32_bf16(B0, v1[j], acc[0][j], 0, 0, 0); acc[1][j] = __builtin_amdgcn_mfma_f32_16x16x32_bf16(B1, v1[j], acc[1][j], 0, 0, 0); }
                __builtin_amdgcn_s_setprio(0);
            }
            if (((u + 1) & 7) == 0) {
                const int kb = (u + 1) >> 3, slot = dir ? (N - 1 - kb) : (kb - 1);
                bf16_t* sp = stbase + ((size_t)slot << 17);
#pragma unroll
                for (int i = 0; i < 2; ++i)
#pragma unroll
                    for (int j = 0; j < 4; ++j) { const f32x4 sv = acc[i][j]; u32x2 w; w.x = f2bf_rne(sv.x) | (f2bf_rne(sv.y) << 16); w.y = f2bf_rne(sv.z) | (f2bf_rne(sv.w) << 16);
                        *(u32x2*)(sp + (size_t)(16 * j) * 256 + 16 * i) = w; }
#pragma unroll
                for (int i = 0; i < 2; ++i)
#pragma unroll
                    for (int j = 0; j < 4; ++j) acc[i][j] = acc[i][j] * d512;
            }
        }
#undef CH_DMA
        asm volatile("s_waitcnt vmcnt(0) lgkmcnt(0)" ::: "memory");
        __builtin_amdgcn_s_barrier();
        asm volatile("" ::: "memory");
    }
}

__device__ __forceinline__ void retention_phase(LAS unsigned char* lds, const bf16_t* Q, const bf16_t* Kb, const bf16_t* VT, const bf16_t* ST, bf16_t* A3s  , int S) {
    const int N = S / BLK;
    for (int item = blockIdx.x; item < (SLAB / 128) * 4; item += gridDim.x) {
        int tid_ = threadIdx.x; asm volatile("" : "+v"(tid_));
        const int tid = tid_, wid = __builtin_amdgcn_readfirstlane(tid >> 6), lane = tid & 63, wr = wid >> 2, wc = wid & 3, fr = lane & 15, fq = lane >> 4;
        const int fragoff = (fr * 64 + fq * 16) ^ (((fr >> 3) & 1) << 5);
        const int sb = lane * 16, swz = sb ^ (((sb >> 9) & 1) << 5), dR = swz >> 6, dC = (swz & 63) >> 1;
        LAS f32x2* RED = (LAS f32x2*)(lds);
        const int qpp = S / 128  , jj = item >> 3, pr = (item & 7) + 8 * (jj / qpp), qb = jj % qpp;
        const int h = pr & 3, sq = pr >> 2, seq0 = sq * S, row0 = seq0 + 128 * qb, qpos0 = 128 * qb, n = qpos0 / BLK, blk0 = seq0 + BLK * n;
        const float lf = lg_f(h), lb = lg_b(h);
        const int nF = (n > 0) ? 8 : 0, nB = (n < N - 1) ? 8 : 0, nsteps = 16 + nF + nB;
        bf16x8 qa[8];
        { const bf16_t* qp = Q + (size_t)(row0 + 16 * wid + fr) * 1024 + 256 * h + 8 * fq;
#pragma unroll
          for (int s = 0; s < 8; ++s) qa[s] = *(const bf16x8*)(qp + 32 * s); }
        f32x4 acc[4][8];
#pragma unroll
        for (int a = 0; a < 4; ++a)
#pragma unroll
            for (int b = 0; b < 8; ++b) acc[a][b] = (f32x4){0.f, 0.f, 0.f, 0.f};
        const bf16_t* kbase = Kb + (size_t)blk0 * 1024 + 256 * h;
        const bf16_t* vbase = VT + (size_t)(512 * h) * SLAB + blk0;
        const bf16_t* fbase = ST + ((size_t)(((sq * 4 + h) * 2 + 0) * (N - 1) + (n - 1)) << 17);
        const bf16_t* bbase = ST + ((size_t)(((sq * 4 + h) * 2 + 1) * (N - 1) + n) << 17);
        const unsigned lok = (unsigned)(dR * 1024 + dC) * 2u, lov = (unsigned)(dR * SLAB + dC) * 2u, los = (unsigned)(dR * 256 + dC) * 2u;
#define RT_ISSUE(st_) do { const int _b = (st_) % 3, _e = ((st_) < nsteps) ? (st_) : 0, _kt = (_e < 16) ? _e : 0; \
        _Pragma("unroll") for (int _j = 0; _j < 2; ++_j) { const int _st = 2 * wid + _j; \
            __builtin_amdgcn_global_load_lds((const unsigned*)((const char*)(kbase + (size_t)(32 * _kt + 16 * (_st >> 3)) * 1024 + 32 * (_st & 7)) + lok), (LAS unsigned*)(lds + _b * 16384 + _st * 1024), 16, 0, 0); } \
        if (_e < 16) { \
            _Pragma("unroll") for (int _j = 0; _j < 4; ++_j) { const int _st = 4 * wid + _j; \
                __builtin_amdgcn_global_load_lds((const unsigned*)((const char*)(vbase + (size_t)(16 * _st) * SLAB + 32 * _e) + lov), (LAS unsigned*)(lds + 49152 + _b * 32768 + _st * 1024), 16, 0, 0); } \
        } else { const bf16_t* _sb = (_e < 16 + nF) ? fbase + 32 * (_e - 16) : bbase + 32 * (_e - 16 - nF); \
            _Pragma("unroll") for (int _j = 0; _j < 4; ++_j) { const int _st = 4 * wid + _j; \
                __builtin_amdgcn_global_load_lds((const unsigned*)((const char*)(_sb + (size_t)(16 * _st) * 256) + los), (LAS unsigned*)(lds + 49152 + _b * 32768 + _st * 1024), 16, 0, 0); } } } while (0)
        const int qib = (qpos0 & (BLK - 1)) + 16 * wid + fr;
        const float df = __builtin_amdgcn_exp2f(lf * (float)(qib + 1)), db = __builtin_amdgcn_exp2f(lb * (float)(BLK - qib));
        asm volatile("s_waitcnt vmcnt(0)" ::: "memory");
        RT_ISSUE(0); RT_ISSUE(1);
#pragma unroll 1
        for (int st = 0; st < nsteps; ++st) {
            const int b = st % 3;
            asm volatile("s_waitcnt vmcnt(6)" ::: "memory");
            __builtin_amdgcn_s_barrier();
            asm volatile("" ::: "memory");
            RT_ISSUE(st + 2);
            LAS unsigned char* ps = lds + 147456;
            if (st < 16) {
                LAS unsigned char* ks = lds + b * 16384 + fragoff;
                {
                    f32x4 p0 = {0.f, 0.f, 0.f, 0.f}, p1 = {0.f, 0.f, 0.f, 0.f}; bf16x8 ka[4], kb[4];
#define RT_LDK(dst, t2_, s0_) do { _Pragma("unroll") for (int s = 0; s < 4; ++s) dst[s] = *(const LAS bf16x8*)(ks + ((t2_) * 8 + (s0_) + s) * 1024); } while (0)
#define RT_MMK(pp, src_, s0_) do { _Pragma("unroll") for (int s = 0; s < 4; ++s) pp = __builtin_amdgcn_mfma_f32_16x16x32_bf16(src_[s], qa[(s0_) + s], pp, 0, 0, 0); } while (0)
                    RT_LDK(ka, 0, 0); RT_LDK(kb, 0, 4); __builtin_amdgcn_sched_barrier(0);
                    __builtin_amdgcn_s_setprio(1);
                    RT_MMK(p0, ka, 0); RT_LDK(ka, 1, 0); __builtin_amdgcn_sched_barrier(0);
                    RT_MMK(p0, kb, 4); RT_LDK(kb, 1, 4); __builtin_amdgcn_sched_barrier(0);
                    RT_MMK(p1, ka, 0); RT_MMK(p1, kb, 4);
                    __builtin_amdgcn_s_setprio(0);
#undef RT_LDK
#undef RT_MMK
#pragma unroll
                    for (int t2 = 0; t2 < 2; ++t2) { f32x4 p = t2 ? p1 : p0;
                        const int dd = qib - (32 * st + 16 * t2 + 4 * fq);
#pragma unroll
                        for (int i = 0; i < 4; ++i) { const int d = dd - i; const float e = (d >= 0) ? lf * (float)d : lb * (float)(-d); p[i] *= __builtin_amdgcn_exp2f(e); }
                        const int ob = fr * 64 + (16 * t2 + 4 * fq) * 2;
                        u32x2 w; w.x = cvt_pk_bf16(p[0], p[1]); w.y = cvt_pk_bf16(p[2], p[3]);
                        *(LAS u32x2*)(ps + wid * 1024 + (ob ^ (((ob >> 9) & 1) << 5))) = w; }
                }
            } else {
                bf16x8 qv;
                switch (st & 7) { case 0: qv = qa[0]; break; case 1: qv = qa[1]; break; case 2: qv = qa[2]; break; case 3: qv = qa[3]; break;
                                  case 4: qv = qa[4]; break; case 5: qv = qa[5]; break; case 6: qv = qa[6]; break; default: qv = qa[7]; break; }
                *(LAS bf16x8*)(ps + wid * 1024 + fragoff) = scale8s(qv, (st < 16 + nF) ? df : db);
            }
            asm volatile("s_waitcnt lgkmcnt(0)" ::: "memory");
            __builtin_amdgcn_s_barrier();
            asm volatile("" ::: "memory");
            {
                bf16x8 pf[4], va[4], vb[4];
#pragma unroll
                for (int mt = 0; mt < 4; ++mt) pf[mt] = *(const LAS bf16x8*)(ps + (4 * wr + mt) * 1024 + fragoff);
#pragma unroll
                for (int nt2 = 0; nt2 < 4; ++nt2) va[nt2] = *(const LAS bf16x8*)(lds + 49152 + b * 32768 + (8 * wc + nt2) * 1024 + fragoff);
                __builtin_amdgcn_sched_barrier(0);
                __builtin_amdgcn_s_setprio(1);
#pragma unroll
                for (int nt2 = 0; nt2 < 4; ++nt2) vb[nt2] = *(const LAS bf16x8*)(lds + 49152 + b * 32768 + (8 * wc + 4 + nt2) * 1024 + fragoff);
#pragma unroll
                for (int nt2 = 0; nt2 < 4; ++nt2)
#pragma unroll
                    for (int mt = 0; mt < 4; ++mt) acc[mt][nt2] = __builtin_amdgcn_mfma_f32_16x16x32_bf16(va[nt2], pf[mt], acc[mt][nt2], 0, 0, 0);
                __builtin_amdgcn_sched_group_barrier(0x8, 1, 0); __builtin_amdgcn_sched_group_barrier(0x100, 4, 0); __builtin_amdgcn_sched_group_barrier(0x8, 15, 0);
                __builtin_amdgcn_sched_barrier(0);
#pragma unroll
                for (int nt2 = 0; nt2 < 4; ++nt2)
#pragma unroll
                    for (int mt = 0; mt < 4; ++mt) acc[mt][4 + nt2] = __builtin_amdgcn_mfma_f32_16x16x32_bf16(vb[nt2], pf[mt], acc[mt][4 + nt2], 0, 0, 0);
                __builtin_amdgcn_sched_barrier(0);
                __builtin_amdgcn_s_setprio(0);
            }
        }
#undef RT_ISSUE
        asm volatile("s_waitcnt vmcnt(0)" ::: "memory");
        __builtin_amdgcn_s_barrier();
        asm volatile("" ::: "memory");
        int fr_e = fr, fq_e = fq; asm volatile("" : "+v"(fr_e), "+v"(fq_e));
#pragma unroll
        for (int mt = 0; mt < 4; ++mt) { float s1 = 0.f, s2 = 0.f;
#pragma unroll
            for (int nt2 = 0; nt2 < 8; ++nt2) { const f32x4 v = acc[mt][nt2]; s1 += (v.x + v.y) + (v.z + v.w); s2 += (v.x * v.x + v.y * v.y) + (v.z * v.z + v.w * v.w); }
            { const int ln = fr_e + 16 * fq_e; s1 += shx(s1, 16, ln); s1 += shx(s1, 32, ln); s2 += shx(s2, 16, ln); s2 += shx(s2, 32, ln); }
            if (fq_e == 0) RED[(64 * wr + 16 * mt + fr_e) * 4 + wc] = (f32x2){s1, s2}; }
        asm volatile("s_waitcnt lgkmcnt(0)" ::: "memory");
        __builtin_amdgcn_s_barrier();
        asm volatile("" ::: "memory");
#pragma unroll
        for (int mt = 0; mt < 4; ++mt) { const int row = 64 * wr + 16 * mt + fr_e;
            const f32x2 a = RED[row * 4 + 0], b2 = RED[row * 4 + 1], c2 = RED[row * 4 + 2], d2 = RED[row * 4 + 3];
            const float mean = ((a.x + b2.x) + (c2.x + d2.x)) * (1.0f / 512.0f);
            float var = ((a.y + b2.y) + (c2.y + d2.y)) * (1.0f / 512.0f) - mean * mean; var = var > 0.f ? var : 0.f;
            const float rstd = __builtin_amdgcn_rsqf(var + EPS);
            bf16_t* gp = A3s + (size_t)(row0 + row) * DVW + 512 * h + 128 * wc + 4 * fq_e;
            u32x2 gwv[8];
#pragma unroll
            for (int nt2 = 0; nt2 < 8; ++nt2) gwv[nt2] = *(const u32x2*)(gp + 16 * nt2);
            EPI_FENCE();
#pragma unroll
            for (int nt2 = 0; nt2 < 8; ++nt2) { const u32x2 gw = gwv[nt2]; const f32x4 v = acc[mt][nt2];
                u32x2 w; w.x = cvt_pk_bf16((v.x - mean) * rstd * bf_lo(gw.x), (v.y - mean) * rstd * bf_hi(gw.x)); w.y = cvt_pk_bf16((v.z - mean) * rstd * bf_lo(gw.y), (v.w - mean) * rstd * bf_hi(gw.y));
                *(u32x2*)(gp + 16 * nt2) = w; }
            EPI_FENCE(); }
        asm volatile("s_waitcnt lgkmcnt(0)" ::: "memory");
        __builtin_amdgcn_s_barrier();
        asm volatile("" ::: "memory");
    }
}

struct Args { const float* in[17]; float* out; unsigned char* ws; };
typedef const __attribute__((address_space(4))) Args* ArgsP;
__device__ __forceinline__ ArgsP largs() { ArgsP p = (ArgsP)__builtin_amdgcn_kernarg_segment_ptr(); asm volatile("" : "+s"(p)); return p; }
#define WSB(off) ((bf16_t*)(ws + (off)))

__global__ void __launch_bounds__(512, 2) mega_fwd(Args a_unused) {
    extern __shared__ __attribute__((aligned(16))) unsigned char lds_raw[];
    LAS unsigned char* lds = (LAS unsigned char*)lds_raw;
    const int G = gridDim.x, bx = blockIdx.x;
#define PH_IDS() int tid = threadIdx.x; asm volatile("" : "+v"(tid)); const int lane = tid & 63, wave = __builtin_amdgcn_readfirstlane(tid >> 6), gw = bx * 8 + wave, ngw = G * 8; (void)lane; (void)gw; (void)ngw
    { const int tid = threadIdx.x;
      volatile LAS unsigned* MISC = (volatile LAS unsigned*)(lds + MISC_OFF); if (tid < 32) MISC[tid] = 0u; }
    __syncthreads();
    XcdBarrier bar = xcd_barrier_post((unsigned*)(largs()->ws + WS_CTL) + CW_BAR, (volatile LAS unsigned*)(lds + MISC_OFF) + 8);
#define GRID_BAR() xcd_barrier(bar)

    {
        PH_IDS(); ArgsP a = largs(); unsigned char* ws = a->ws;
        LAS float* scr = (LAS float*)(lds + wave * 16384);
        constexpr int I_WIN = 96 * 16, I_WOUT = 32 * 16, I_UP = 128 * 16, I_DN = 32 * 64, I_QKG = 128 * 16, I_V = 64 * 16, I_O = 32 * 32;
        constexpr int NITEMS = I_WIN + I_WOUT + 2 * I_UP + 2 * I_DN + I_QKG + I_V + I_O;
        const int nit = (G > 128) ? NITEMS - (I_O + I_UP + I_DN) : NITEMS;
        for (int it = gw; it < nit; it += ngw) {
            int r = it;
            if (r < I_WIN) { const int nb = r % 96, kb = r / 96, n0 = 32 * nb, pn = n0 >> 8, j = n0 & 255;
                const int src = (pn < 8) ? ((j >> 7) ? 2048 : 0) + 128 * pn + (j & 127) : 1024 + (n0 - 2048);
                transpose_item(a->in[3], 1024, 3072, a->in[2], WSB(WS_WIN), n0, src, 64 * kb, scr, lane); continue; } r -= I_WIN;
            if (r < I_WOUT) { const int nb = r % 32, kb = r / 32; transpose_item(a->in[6], 1024, 1024, nullptr, WSB(WS_WOUT), 32 * nb, 32 * nb, 64 * kb, scr, lane); continue; } r -= I_WOUT;
            if (r < I_UP) { const int nb = r % 128, kb = r / 128; transpose_item(a->in[8], 1024, 4096, a->in[7], WSB(WS_WUP0), 32 * nb, 32 * nb, 64 * kb, scr, lane); continue; } r -= I_UP;
            if (r < I_DN) { const int nb = r % 32, kb = r / 32; transpose_item(a->in[9], 4096, 1024, nullptr, WSB(WS_WDN0), 32 * nb, 32 * nb, 64 * kb, scr, lane); continue; } r -= I_DN;
            if (r < I_QKG) { const int nb = r % 128, kb = r / 128, n0 = 32 * nb; transpose_item(a->in[11], 1024, 6144, a->in[10], WSB(WS_WQKG), n0, n0 < 2048 ? n0 : n0 + 2048, 64 * kb, scr, lane); continue; } r -= I_QKG;
            if (r < I_V) { const int nb = r % 64, kb = r / 64; transpose_item(a->in[11], 1024, 6144, a->in[10], WSB(WS_WV), 32 * nb, 2048 + 32 * nb, 64 * kb, scr, lane); continue; } r -= I_V;
            if (r < I_O) { const int nb = r % 32, kb = r / 32; transpose_item(a->in[12], 2048, 1024, nullptr, WSB(WS_WO), 32 * nb, 32 * nb, 64 * kb, scr, lane); continue; } r -= I_O;
            if (r < I_UP) { const int nb = r % 128, kb = r / 128; transpose_item(a->in[14], 1024, 4096, a->in[13], WSB(WS_WUP1), 32 * nb, 32 * nb, 64 * kb, scr, lane); continue; } r -= I_UP;
            { const int nb = r % 32, kb = r / 32; transpose_item(a->in[15], 4096, 1024, nullptr, WSB(WS_WDN1), 32 * nb, 32 * nb, 64 * kb, scr, lane); }
        }
        float* rope = (float*)(ws + WS_ROPE);
        for (int idx = bx * 512 + tid; idx < 4096 * 128; idx += G * 512) rope_entry(rope, idx);
        xb_prep(a->in[0], WSB(WS_XB), (float*)(ws + WS_SSP), gw, ngw, lane);
    }
    GRID_BAR();
    if (gridDim.y == 7777u) cg::this_grid().sync();

    for (int g = 0; g < 2; ++g) {
        const int S = g ? 2048 : 4096;
        { ArgsP a = largs(); unsigned char* ws = a->ws;
          pg8::StaticOrder<MG, 3072> so; so.init(G, bx); EpiConvIn E{WSB(WS_U), WSB(WS_GB), (const float*)(ws + WS_SSP + (size_t)(2 * g) * MiB)}; pg8::gemm_phase<D, D, D>(lds, g ? (const bf16_t*)(a->out + (size_t)MG * D) : WSB(WS_XB), WSB(WS_WIN), so, E); }
        GRID_BAR();
        {
            PH_IDS(); ArgsP a = largs(); unsigned char* ws = a->ws;
            const float* cw = a->in[4]; const float* cbv = a->in[5]; const bf16_t* Ub = WSB(WS_U); const bf16_t* GBb = WSB(WS_GB); bf16_t* A2 = WSB(WS_A2);
            const int ch0 = bx * 512 + tid, c = (ch0 & 127) * 8, tstep = (G * 512) >> 7;
            const f32x4 w0a = *(const f32x4*)(cw + c), w0b = *(const f32x4*)(cw + c + 4), w1a = *(const f32x4*)(cw + D + c), w1b = *(const f32x4*)(cw + D + c + 4), w2a = *(const f32x4*)(cw + 2 * D + c), w2b = *(const f32x4*)(cw + 2 * D + c + 4);
            const f32x4 ba = *(const f32x4*)(cbv + c), bb = *(const f32x4*)(cbv + c + 4);
            for (int t = ch0 >> 7; t < MG; t += tstep) {
                const int pos = t & (S - 1);
                const u32x4 z4 = {0u, 0u, 0u, 0u};
                const u32x4 um = (pos > 0) ? *(const u32x4*)(Ub + (size_t)(t - 1) * D + c) : z4;
                const u32x4 u0 = *(const u32x4*)(Ub + (size_t)t * D + c);
                const u32x4 up = (pos < S - 1) ? *(const u32x4*)(Ub + (size_t)(t + 1) * D + c) : z4;
                const u32x4 gb = __builtin_nontemporal_load((const u32x4*)(GBb + (size_t)t * D + c));
                f32x4 za, zb;
                za.x = ba.x + w0a.x * bf_lo(um.x) + w1a.x * bf_lo(u0.x) + w2a.x * bf_lo(up.x); za.y = ba.y + w0a.y * bf_hi(um.x) + w1a.y * bf_hi(u0.x) + w2a.y * bf_hi(up.x);
                za.z = ba.z + w0a.z * bf_lo(um.y) + w1a.z * bf_lo(u0.y) + w2a.z * bf_lo(up.y); za.w = ba.w + w0a.w * bf_hi(um.y) + w1a.w * bf_hi(u0.y) + w2a.w * bf_hi(up.y);
                zb.x = bb.x + w0b.x * bf_lo(um.z) + w1b.x * bf_lo(u0.z) + w2b.x * bf_lo(up.z); zb.y = bb.y + w0b.y * bf_hi(um.z) + w1b.y * bf_hi(u0.z) + w2b.y * bf_hi(up.z);
                zb.z = bb.z + w0b.z * bf_lo(um.w) + w1b.z * bf_lo(u0.w) + w2b.z * bf_lo(up.w); zb.w = bb.w + w0b.w * bf_hi(um.w) + w1b.w * bf_hi(u0.w) + w2b.w * bf_hi(up.w);
                za.x *= bf_lo(gb.x); za.y *= bf_hi(gb.x); za.z *= bf_lo(gb.y); za.w *= bf_hi(gb.y); zb.x *= bf_lo(gb.z); zb.y *= bf_hi(gb.z); zb.z *= bf_lo(gb.w); zb.w *= bf_hi(gb.w);
                *(u32x4*)(A2 + (size_t)t * D + c) = pack8(za, zb);
            }
        }
        GRID_BAR();
        { ArgsP a = largs(); unsigned char* ws = a->ws;
          pg8::StaticOrder<MG, D> so; so.init(G, bx);
          EpiRes E{a->in[g], WSB(WS_XB), (float*)(ws + WS_SSP + (size_t)(2 * g + 1) * MiB)}; pg8::gemm_phase<D, D, D>(lds, WSB(WS_A2), WSB(WS_WOUT), so, E); }
        GRID_BAR();
        { ArgsP a = largs(); unsigned char* ws = a->ws;
          pg8::StaticOrder<MG, FF> so; so.init(G, bx); EpiUp E{WSB(WS_HID), (const float*)(ws + WS_SSP + (size_t)(2 * g + 1) * MiB)}; pg8::gemm_phase<D, D, D>(lds, WSB(WS_XB), WSB(WS_WUP0), so, E); }
        GRID_BAR();
        { ArgsP a = largs(); unsigned char* ws = a->ws;
          pg8::StaticOrder<MG, D> so; so.init(G, bx); EpiRes E{nullptr, WSB(WS_XB), (float*)(ws + WS_SSP + (size_t)(2 * g) * MiB)}; pg8::gemm_phase<FF, FF, FF>(lds, WSB(WS_HID), WSB(WS_WDN0), so, E); }
        GRID_BAR();
        for (int sl = 0; sl < 2; ++sl) {
            { ArgsP a = largs(); unsigned char* ws = a->ws;
              const bf16_t* XBs = WSB(WS_XB) + (size_t)sl * SLAB * D; const float* sps = (const float*)(ws + WS_SSP + (size_t)(2 * g) * MiB) + (size_t)sl * SLAB * 16;
              QkvOrder so; so.init(G, bx);
              bf16_t* KFp = (bf16_t*)(a->out + (size_t)g * MG * D); bf16_t* KWp = KFp + (size_t)SLAB * 1024;
              EpiQKVG E{EpiQKG{WSB(WS_Q), WSB(WS_K), KFp, KWp, WSB(WS_A3) + (size_t)sl * SLAB * DVW, sps, (const float*)(ws + WS_ROPE), S - 1}, EpiVT{WSB(WS_VT), sps}};
              pg8::gemm_phase<D, D, D>(lds, XBs, WSB(WS_WQKG), so, E, WSB(WS_WV), XBs); }
            GRID_BAR();
            { ArgsP a = largs(); unsigned char* ws = a->ws;
              const bf16_t* KFp = (const bf16_t*)(a->out + (size_t)g * MG * D);
              chain_phase(lds, KFp, KFp + (size_t)SLAB * 1024, WSB(WS_VT), WSB(WS_ST), S, SLAB / S);
              if (g == 0 && bx >= 128) {
                  PH_IDS(); (void)gw; (void)ngw;
                  const size_t ro = (size_t)sl * SLAB;
                  xb_prep(a->in[1] + ro * D, (bf16_t*)(a->out + (size_t)MG * D) + ro * D, (float*)(ws + WS_SSP + 2 * MiB) + ro * 16, (bx - 128) * 8 + wave, (G - 128) * 8, lane, SLAB);
                  LAS float* scr = (LAS float*)(lds + wave * 16384);
                  const int iw = (bx - 128) * 8 + wave, niw = (G - 128) * 8;
                  if (sl == 0) { for (int it = iw; it < 32 * 32 + 128 * 16; it += niw) {
                          if (it < 32 * 32) { const int nb = it % 32, kb = it / 32; transpose_item(a->in[12], 2048, 1024, nullptr, WSB(WS_WO), 32 * nb, 32 * nb, 64 * kb, scr, lane); }
                          else { const int r = it - 32 * 32, nb = r % 128, kb = r / 128; transpose_item(a->in[14], 1024, 4096, a->in[13], WSB(WS_WUP1), 32 * nb, 32 * nb, 64 * kb, scr, lane); } } }
                  else { for (int it = iw; it < 32 * 64; it += niw) { const int nb = it % 32, kb = it / 32; transpose_item(a->in[15], 4096, 1024, nullptr, WSB(WS_WDN1), 32 * nb, 32 * nb, 64 * kb, scr, lane); } } } }
            GRID_BAR();
            { ArgsP a = largs(); unsigned char* ws = a->ws;
              retention_phase(lds, WSB(WS_Q), WSB(WS_K), WSB(WS_VT), WSB(WS_ST), WSB(WS_A3) + (size_t)sl * SLAB * DVW, S); }
            GRID_BAR();
        }
        { ArgsP a = largs(); unsigned char* ws = a->ws;
          pg8::StaticOrder<MG, D> so; so.init(G, bx); EpiRes E{nullptr, WSB(WS_XB), (float*)(ws + WS_SSP + (size_t)(2 * g + 1) * MiB)}; pg8::gemm_phase<DVW, DVW, DVW>(lds, WSB(WS_A3), WSB(WS_WO), so, E); }
        GRID_BAR();
        { ArgsP a = largs(); unsigned char* ws = a->ws;
          pg8::StaticOrder<MG, FF> so; so.init(G, bx); EpiUp E{WSB(WS_HID), (const float*)(ws + WS_SSP + (size_t)(2 * g + 1) * MiB)}; pg8::gemm_phase<D, D, D>(lds, WSB(WS_XB), WSB(WS_WUP1), so, E); }
        GRID_BAR();
        { ArgsP a = largs(); unsigned char* ws = a->ws;
          pg8::StaticOrder<MG, D> so; so.init(G, bx);
          EpiFinal E{WSB(WS_XB), a->out + (size_t)g * MG * D, (float*)(ws + WS_SSP + (size_t)(2 * g) * MiB), a->in[16], (unsigned*)(ws + WS_CTL) + CW_FIN + g * 64 * 64};
          pg8::gemm_phase<FF, FF, FF>(lds, WSB(WS_HID), WSB(WS_WDN1), so, E); }
        if (g == 0) GRID_BAR();
    }
}

extern "C" void kernel_launch(void* const* d_in, const int* in_sizes, int n_in, void* d_out, int out_size, void* d_ws, size_t ws_size, hipStream_t stream) {
    static int grid = 0;
    if (grid == 0) {
        if (n_in != 17 || out_size != 2 * MG * D || ws_size < WS_END) { fprintf(stderr, "kernel_launch: unexpected shapes (n_in %d out %d ws %zu); nothing launched\n", n_in, out_size, ws_size); grid = -1; return; }
        int dev = 0, cus = 0, per_cu = 0;
        if (hipGetDevice(&dev) != hipSuccess || hipDeviceGetAttribute(&cus, hipDeviceAttributeMultiprocessorCount, dev) != hipSuccess) { grid = -1; return; }
        if (hipFuncSetAttribute((const void*)mega_fwd, hipFuncAttributeMaxDynamicSharedMemorySize, LDS_BYTES) != hipSuccess) { fprintf(stderr, "kernel_launch: hipFuncSetAttribute failed\n"); grid = -1; return; }
        if (hipOccupancyMaxActiveBlocksPerMultiprocessor(&per_cu, (const void*)mega_fwd, 512, LDS_BYTES) != hipSuccess || per_cu < 1) { fprintf(stderr, "kernel_launch: occupancy query says %d blocks/CU\n", per_cu); (void)hipGetLastError(); grid = -1; return; }
        grid = cus;
    }
    if (grid < 0) return;
    (void)hipMemsetAsync((char*)d_ws + WS_CTL, 0, CTL_ZERO_BYTES, stream);
    Args a{};
    for (int i = 0; i < 17; ++i) a.in[i] = (const float*)d_in[i];
    a.out = (float*)d_out; a.ws = (unsigned char*)d_ws;
    void* args[] = {&a};
    hipError_t e = hipLaunchCooperativeKernel((const void*)mega_fwd, dim3(grid), dim3(512), args, LDS_BYTES, stream);
    if (e != hipSuccess) fprintf(stderr, "cooperative launch failed: %s (grid %d)\n", hipGetErrorString(e), grid);
}
```

```cpp
#include <hip/hip_runtime.h>
#include <hip/hip_cooperative_groups.h>
#include <cstdio>
namespace cg = cooperative_groups;

#define LAS __attribute__((address_space(3)))
typedef unsigned short bf16_t;
typedef short bf16x8 __attribute__((ext_vector_type(8)));
typedef float f32x4 __attribute__((ext_vector_type(4)));
typedef float f32x2 __attribute__((ext_vector_type(2)));
typedef unsigned u32x4 __attribute__((ext_vector_type(4)));
typedef unsigned u32x2 __attribute__((ext_vector_type(2)));

constexpr int D = 1024, MG = 16384  , FF = 4096, SLAB = 8192, DVW = 2048;
constexpr float EPS = 1e-6f;
constexpr size_t MiB = 1u << 20;
constexpr size_t WS_CTL = 0, CTL_ZERO_BYTES = 65536;
constexpr size_t WS_SSP = 1 * MiB;
constexpr size_t WS_WIN = 8 * MiB, WS_WOUT = 14 * MiB, WS_WUP0 = 16 * MiB, WS_WDN0 = 24 * MiB, WS_WQKG = 32 * MiB, WS_WV = 40 * MiB, WS_WO = 44 * MiB, WS_WUP1 = 48 * MiB, WS_WDN1 = 56 * MiB;
constexpr size_t WS_XB = 64 * MiB;
constexpr size_t WS_BIG = 96 * MiB;
constexpr size_t WS_U = WS_BIG, WS_GB = WS_BIG + 32 * MiB, WS_A2 = WS_BIG + 64 * MiB;
constexpr size_t WS_HID = WS_BIG;
constexpr size_t WS_A3 = WS_BIG;
constexpr size_t WS_Q = WS_BIG + 64 * MiB, WS_K = WS_BIG + 80 * MiB, WS_VT = WS_BIG + 96 * MiB;
constexpr size_t WS_ROPE = 224 * MiB;
constexpr size_t WS_ST = 228 * MiB;
constexpr size_t WS_END = 256 * MiB;
constexpr int CW_FIN = 8192;
constexpr int CW_BAR = 4096;
constexpr int LDS_BYTES = 158720;
constexpr int MISC_OFF = 155648, RTAB_OFF = 156160;

__device__ __forceinline__ unsigned cvt_pk_bf16(float lo, float hi) { unsigned r; asm volatile("v_cvt_pk_bf16_f32 %0, %1, %2" : "=v"(r) : "v"(lo), "v"(hi)); return r; }
__device__ __forceinline__ float shx(float v, int mask, int lane) { return __builtin_bit_cast(float, __builtin_amdgcn_ds_bpermute((lane ^ mask) << 2, __builtin_bit_cast(int, v))); }
__device__ __forceinline__ unsigned f2bf_rne(float f) { const unsigned u = __float_as_uint(f); return (u + 0x7fffu + ((u >> 16) & 1u)) >> 16; }
__device__ __forceinline__ float bf_lo(unsigned w) { return __uint_as_float(w << 16); }
__device__ __forceinline__ float bf_hi(unsigned w) { return __uint_as_float(w & 0xffff0000u); }

#define XB_TMO      128
#define XB_XCNT(j)  (256  + 64 * (j))
#define XB_XSUB(j)  (1280 + 64 * (j))
#define XB_XGEN(j)  (2304 + 64 * (j))
#define XB_TOP      3328
#define XB_TOPGEN   3392
#define XCD_BAR_WORDS 3456
#define XB_SPIN_CAP (1u << 20)
__device__ __forceinline__ unsigned xb_ld(unsigned* p)              { return __hip_atomic_load(p, __ATOMIC_RELAXED, __HIP_MEMORY_SCOPE_AGENT); }
__device__ __forceinline__ unsigned xb_add(unsigned* p, unsigned v) { return __hip_atomic_fetch_add(p, v, __ATOMIC_RELAXED, __HIP_MEMORY_SCOPE_AGENT); }
__device__ __forceinline__ unsigned xb_xcc_id() { return (unsigned)__builtin_amdgcn_s_getreg((3 << 11) | 20) & 0xFu; }
#define XB_SPIN(cond, bar) do { unsigned _sp = 0; while (cond) { __builtin_amdgcn_s_sleep(1); \
    if ((++_sp & 255u) == 0u) { if (xb_ld(&(bar)[XB_TMO])) break; if (_sp > XB_SPIN_CAP) { atomicAdd(&(bar)[XB_TMO], 1u); break; } } } } while (0)
struct XcdBarrier { unsigned* bar; unsigned x; volatile LAS unsigned* st; };
__device__ __forceinline__ XcdBarrier xcd_barrier_post(unsigned* bar, volatile LAS unsigned* st) {
    XcdBarrier b; b.bar = bar; b.x = xb_xcc_id(); b.st = st;
    if (threadIdx.x == 0) (void)xb_add(&bar[XB_XCNT(b.x)], 1u);
    return b;
}
__device__ __forceinline__ void xcd_barrier_complete(unsigned* bar, unsigned x, unsigned& nloc, unsigned& nx) {
    const unsigned G = gridDim.x * gridDim.y * gridDim.z;
    unsigned sum, cnt, mine, sp = 0u;
    for (;;) {
        sum = 0u; cnt = 0u; mine = 0u;
#pragma unroll
        for (unsigned j = 0; j < 16; ++j) { const unsigned c = xb_ld(&bar[XB_XCNT(j)]); sum += c; cnt += (c > 0u) ? 1u : 0u; mine = (j == x) ? c : mine; }
        if (sum == G) break;
        __builtin_amdgcn_s_sleep(1);
        if ((++sp & 255u) == 0u) { if (xb_ld(&bar[XB_TMO])) break; if (sp > XB_SPIN_CAP) { atomicAdd(&bar[XB_TMO], 1u); break; } }
    }
    nloc = mine > 0u ? mine : 1u; nx = cnt > 0u ? cnt : 1u;
}
__device__ __forceinline__ void xcd_barrier(const XcdBarrier& b) {
    asm volatile("s_waitcnt vmcnt(0)" ::: "memory");
    __syncthreads();
    if (threadIdx.x == 0) {
        unsigned* bar = b.bar;
        __builtin_amdgcn_s_waitcnt(0);
        unsigned nloc = b.st[0], nx = b.st[1];
        if (nloc == 0u) { xcd_barrier_complete(bar, b.x, nloc, nx); b.st[0] = nloc; b.st[1] = nx; }
        const unsigned old = xb_add(&bar[XB_XSUB(b.x)], 1u);
        const unsigned gen = old / nloc;
        if (old + 1u == (gen + 1u) * nloc) {
            __builtin_amdgcn_fence(__ATOMIC_RELEASE, "agent");
            asm volatile("s_waitcnt vmcnt(0)" ::: "memory");
            const unsigned og = xb_add(&bar[XB_TOP], 1u);
            const unsigned tg = og / nx;
            if (og + 1u == (tg + 1u) * nx) xb_add(&bar[XB_TOPGEN], 1u);
            else XB_SPIN(xb_ld(&bar[XB_TOPGEN]) == tg, bar);
            __builtin_amdgcn_fence(__ATOMIC_ACQUIRE, "agent");
            xb_add(&bar[XB_XGEN(b.x)], 1u);
            asm volatile("s_waitcnt vmcnt(0)" ::: "memory");
        } else {
            XB_SPIN(xb_ld(&bar[XB_XGEN(b.x)]) == gen, bar);
            __builtin_amdgcn_fence(__ATOMIC_ACQUIRE, "agent");
            asm volatile("s_waitcnt vmcnt(0)" ::: "memory");
        }
    }
    __syncthreads();
}

namespace pg8 {
constexpr int BM = 256, BK = 64, HALF = 128, HTB = HALF * BK * 2, STAGE_BYTES = 8 * HTB, NXCD = 8, WGM = 8;
__host__ __device__ __forceinline__ int lds_byte(int r, int c) { const int st = (r >> 4) * 2 + (c >> 5), rr = r & 15, cc = c & 31, ob = rr * 64 + cc * 2; return st * 1024 + (ob ^ (((ob >> 9) & 1) << 5)); }
__host__ __device__ __forceinline__ void stage_rc(int b, int& R, int& C) { const int st = b / 1024, sb = b % 1024, swz = sb ^ (((sb >> 9) & 1) << 5); R = (st >> 1) * 16 + swz / 64; C = (st & 1) * 32 + (swz % 64) / 2; }
__host__ __device__ __forceinline__ int perm32(int rho) { const int n = rho >> 4, i = rho & 15; return 8 * (i >> 2) + 4 * n + (i & 3); }
struct Unit { int pm, pn, ty; };
template <int M_, int N_> struct StaticOrder {
    static constexpr int nM = M_ / BM, nN = N_ / BM, nwg = nM * nN;
    int G, c;
    __device__ __forceinline__ void init(int G_, int c_) { G = G_; c = c_; }
    __device__ __forceinline__ bool next(int i, Unit& u) const {
        const int L = i * G + c; if (L >= nwg) return false;
        int wgid = L; { constexpr int q = nwg / NXCD, r = nwg % NXCD; const int xcd = wgid % NXCD, off = wgid / NXCD; wgid = (xcd < r ? xcd * (q + 1) : r * (q + 1) + (xcd - r) * q) + off; }
        constexpr int nig = WGM * nN; const int gid = wgid / nig, fm = gid * WGM, gsz = (nM - fm) < WGM ? (nM - fm) : WGM;
        u.pm = fm + ((wgid % nig) % gsz); u.pn = (wgid % nig) / gsz; u.ty = 0; return true;
    }
};

template <int LDA, int LDB, int KK, class Epi, class Sched>
__device__ __forceinline__ void gemm_phase(LAS unsigned char* lds, const bf16_t* gA, const bf16_t* gB, const Sched& S, const Epi& E, const bf16_t* gA2 = nullptr, const bf16_t* gB2 = nullptr) {
    int tid_ = threadIdx.x; asm volatile("" : "+v"(tid_));
    const int tid = tid_, wid = __builtin_amdgcn_readfirstlane(tid >> 6), lane = tid & 63, wr = wid >> 2, wc = wid & 3, fr = lane & 15, fq = lane >> 4;
    constexpr int nt = KK / BK;
    unsigned voffA[2], voffB[2];
#pragma unroll
    for (int i = 0; i < 2; ++i) { int R, C; stage_rc(tid * 16 + i * 8192, R, C); const int Rb = Epi::PERM ? ((R & ~31) + perm32(R & 31)) : R;
        voffA[i] = (unsigned)(R * LDA + C) * 2u; voffB[i] = (unsigned)(Rb * LDB + C) * 2u; }
    constexpr size_t kstep = (size_t)(BK * 2);
    constexpr size_t hstepA = (size_t)HALF * LDA * 2, hstepB = (size_t)HALF * LDB * 2;
    constexpr size_t tstepA = 2 * hstepA, tstepB = 2 * hstepB;
    const unsigned ldsw = (unsigned)wid * 1024u;
    const int aoff = lds_byte(wr * 64 + fr, fq * 8), boff = lds_byte(wc * 32 + fr, fq * 8);
#define PG8_SA(b, h) (((b) * 2 + (h)) * HTB)
#define PG8_SB(b, h) ((4 + (b) * 2 + (h)) * HTB)
#define PG8_STAGE(bufoff, gbase, voff) do { _Pragma("unroll") for (int _i = 0; _i < 2; ++_i) \
        __builtin_amdgcn_global_load_lds((const unsigned*)((const char*)(gbase) + (voff)[_i]), (LAS unsigned*)(lds + (bufoff) + ldsw + _i * 8192), 16, 0, 0); } while (0)
#define PG8_LDA(dst, b, h) do { _Pragma("unroll") for (int m = 0; m < 4; ++m) _Pragma("unroll") for (int k = 0; k < 2; ++k) dst[m][k] = *(const LAS bf16x8*)(lds + PG8_SA(b, h) + aoff + m * 2048 + k * 1024); } while (0)
#define PG8_LDB(dst, b, h) do { _Pragma("unroll") for (int n = 0; n < 2; ++n) _Pragma("unroll") for (int k = 0; k < 2; ++k) dst[n][k] = *(const LAS bf16x8*)(lds + PG8_SB(b, h) + boff + n * 2048 + k * 1024); } while (0)
#define PG8_MMA(ai, bj, At, Bt) do { __builtin_amdgcn_s_setprio(1); _Pragma("unroll") for (int m = 0; m < 4; ++m) _Pragma("unroll") for (int n = 0; n < 2; ++n) _Pragma("unroll") for (int k = 0; k < 2; ++k) \
        acc[ai][bj][m][n] = __builtin_amdgcn_mfma_f32_16x16x32_bf16(Bt[n][k], At[m][k], acc[ai][bj][m][n], 0, 0, 0); __builtin_amdgcn_s_setprio(0); } while (0)
#define PG8_WAIT_V(n) asm volatile("s_waitcnt vmcnt(" #n ")" ::: "memory")
#define PG8_WAIT_L(n) asm volatile("s_waitcnt lgkmcnt(" #n ")" ::: "memory")
#define PG8_BAR __builtin_amdgcn_s_barrier()
#define PG8_SCHED __builtin_amdgcn_sched_barrier(0)
    Unit cur, nxt; int ui = 0;
    if (!S.next(0, cur)) return;
    LAS float* rtab = (LAS float*)(lds + RTAB_OFF);
    { const typename Epi::Pre p0 = E.prep_load(cur, tid); E.prep_store(p0, rtab, tid); }
    f32x4 acc[2][2][4][2];
#pragma unroll
    for (int a = 0; a < 2; ++a)
#pragma unroll
        for (int b = 0; b < 2; ++b)
#pragma unroll
            for (int m = 0; m < 4; ++m)
#pragma unroll
                for (int n = 0; n < 2; ++n) acc[a][b][m][n] = (f32x4){0.f, 0.f, 0.f, 0.f};
    bf16x8 At[4][2], B0[2][2], B1[2][2];
    const char* cA = (const char*)(cur.ty ? gA2 : gA) + (size_t)cur.pm * tstepA; const char* cB = (const char*)(cur.ty ? gB2 : gB) + (size_t)cur.pn * tstepB;
    PG8_STAGE(PG8_SB(0, 0), cB, voffB); PG8_STAGE(PG8_SB(0, 1), cB + hstepB, voffB); PG8_STAGE(PG8_SA(0, 0), cA, voffA); PG8_STAGE(PG8_SA(0, 1), cA + hstepA, voffA);
    if (wr == 1) PG8_BAR;
    PG8_WAIT_V(2); PG8_BAR;
    PG8_STAGE(PG8_SB(1, 0), cB + kstep, voffB); PG8_STAGE(PG8_SA(1, 0), cA + kstep, voffA); PG8_STAGE(PG8_SB(1, 1), cB + hstepB + kstep, voffB);
    PG8_WAIT_V(6); PG8_BAR;
    for (;;) {
        const bool has_next = S.next(ui + 1, nxt);
        const char* nA = has_next ? (const char*)(nxt.ty ? gA2 : gA) + (size_t)nxt.pm * tstepA : cA; const char* nB = has_next ? (const char*)(nxt.ty ? gB2 : gB) + (size_t)nxt.pn * tstepB : cB;
        for (int t = 0; t < nt; t += 2) {
            const bool last = (t == nt - 2);
            const char* a1 = cA + (size_t)(t + 1) * kstep;
            const char* a2 = last ? nA : cA + (size_t)(t + 2) * kstep; const char* b2 = last ? nB : cB + (size_t)(t + 2) * kstep;
            const char* a3 = a2 + kstep; const char* b3 = b2 + kstep;
            PG8_LDB(B0, 0, 0); PG8_LDB(B1, 0, 1); PG8_SCHED; PG8_LDA(At, 0, 0); PG8_STAGE(PG8_SA(1, 1), a1 + hstepA, voffA);
            PG8_WAIT_V(8); PG8_WAIT_L(0); PG8_BAR; PG8_MMA(0, 0, At, B0); PG8_MMA(0, 1, At, B1); PG8_BAR; PG8_SCHED;
            PG8_LDA(At, 0, 1); PG8_STAGE(PG8_SB(0, 0), b2, voffB); PG8_STAGE(PG8_SB(0, 1), b2 + hstepB, voffB); PG8_STAGE(PG8_SA(0, 0), a2, voffA);
            PG8_WAIT_V(8); PG8_WAIT_L(0); PG8_BAR; PG8_MMA(1, 0, At, B0); PG8_MMA(1, 1, At, B1); PG8_BAR; PG8_SCHED;
            PG8_LDB(B0, 1, 0); PG8_LDB(B1, 1, 1); PG8_SCHED; PG8_LDA(At, 1, 0); PG8_STAGE(PG8_SA(0, 1), a2 + hstepA, voffA);
            PG8_WAIT_V(8); PG8_WAIT_L(0); PG8_BAR; PG8_MMA(0, 0, At, B0); PG8_MMA(0, 1, At, B1); PG8_BAR; PG8_SCHED;
            PG8_LDA(At, 1, 1); PG8_STAGE(PG8_SB(1, 0), b3, voffB); PG8_STAGE(PG8_SB(1, 1), b3 + hstepB, voffB); PG8_STAGE(PG8_SA(1, 0), a3, voffA);
            PG8_WAIT_V(8); PG8_WAIT_L(0); PG8_BAR; PG8_MMA(1, 0, At, B0); PG8_MMA(1, 1, At, B1); PG8_BAR; PG8_SCHED;
        }
        if (wr == 0) PG8_BAR;
        typename Epi::Pre pre; if (has_next) pre = E.prep_load(nxt, tid);
        if constexpr (Epi::FINAL) E.final(acc, cur, wr, wc, fr, fq, rtab, tid, wid, lane); else E(acc, cur, wr, wc, fr, fq, rtab + (ui & 1) * 256);
        if (!has_next) break;
#pragma unroll
        for (int a = 0; a < 2; ++a)
#pragma unroll
            for (int b = 0; b < 2; ++b)
#pragma unroll
                for (int m = 0; m < 4; ++m)
#pragma unroll
                    for (int n = 0; n < 2; ++n) acc[a][b][m][n] = (f32x4){0.f, 0.f, 0.f, 0.f};
        cur = nxt; cA = nA; cB = nB; ++ui;
        E.prep_store(pre, rtab + (ui & 1) * 256, tid);
        if (wr == 1) PG8_BAR;
    }
    PG8_WAIT_V(0);
    PG8_BAR;
#undef PG8_SA
#undef PG8_SB
#undef PG8_STAGE
#undef PG8_LDA
#undef PG8_LDB
#undef PG8_MMA
#undef PG8_WAIT_V
#undef PG8_WAIT_L
#undef PG8_BAR
#undef PG8_SCHED
}
}

__device__ __forceinline__ float lg_f(int h) { return __builtin_amdgcn_logf(1.0f - __builtin_amdgcn_exp2f(-5.0f - (float)h)); }
__device__ __forceinline__ float lg_b(int h) { return __builtin_amdgcn_logf(1.0f - __builtin_amdgcn_exp2f(-5.5f - (float)h)); }
typedef f32x4 AccT[2][2][4][2];
__device__ __forceinline__ float row_scale(const float* ssp, int r) {
    const f32x4* p = (const f32x4*)(ssp + (size_t)r * 16); const f32x4 a = p[0], b = p[1], c = p[2], d = p[3];
    const float s = ((a.x + a.y) + (a.z + a.w)) + ((b.x + b.y) + (b.z + b.w)) + ((c.x + c.y) + (c.z + c.w)) + ((d.x + d.y) + (d.z + d.w));
    return __builtin_amdgcn_rsqf(s * (1.0f / 1024.0f) + EPS);
}
struct PreNone {};
struct PreSS { f32x4 a, b, c, d; };
__device__ __forceinline__ PreSS ss_load(const float* ssp, int r0, int tid) { PreSS p; if (tid < 256) { const f32x4* q = (const f32x4*)(ssp + (size_t)(r0 + tid) * 16); p.a = q[0]; p.b = q[1]; p.c = q[2]; p.d = q[3]; } else { p.a = p.b = p.c = p.d = (f32x4){0.f, 0.f, 0.f, 0.f}; } return p; }
__device__ __forceinline__ void ss_store(const PreSS& p, LAS float* tab, int tid) {
    const float s = ((p.a.x + p.a.y) + (p.a.z + p.a.w)) + ((p.b.x + p.b.y) + (p.b.z + p.b.w)) + ((p.c.x + p.c.y) + (p.c.z + p.c.w)) + ((p.d.x + p.d.y) + (p.d.z + p.d.w));
    if (tid < 256) tab[tid] = __builtin_amdgcn_rsqf(s * (1.0f / 1024.0f) + EPS); }
__device__ __forceinline__ u32x4 pack8(const f32x4 a, const f32x4 b) { u32x4 w; w.x = cvt_pk_bf16(a.x, a.y); w.y = cvt_pk_bf16(a.z, a.w); w.z = cvt_pk_bf16(b.x, b.y); w.w = cvt_pk_bf16(b.z, b.w); return w; }
#define EPI_FENCE() asm volatile("" ::: "memory")
__device__ __forceinline__ void store_wt(void* p, u32x4 v) { asm volatile("global_store_dwordx4 %0, %1, off sc1\n\ts_nop 1" :: "v"(p), "v"(v) : "memory"); }

struct EpiConvIn { static constexpr bool FINAL = false, PERM = true; bf16_t* U; bf16_t* GB; const float* ssp;
    typedef PreSS Pre;
    __device__ __forceinline__ Pre prep_load(const pg8::Unit& u, int tid) const { return ss_load(ssp, u.pm * 256, tid); }
    __device__ __forceinline__ void prep_store(const Pre& p, LAS float* tab, int tid) const { ss_store(p, tab, tid); }
    __device__ __forceinline__ void operator()(const AccT& acc, const pg8::Unit& u, int wr, int wc, int fr, int fq, const LAS float* tab) const {
        const int rl0 = wr * 64 + fr;
#pragma unroll
        for (int ai = 0; ai < 2; ++ai)
#pragma unroll
            for (int m = 0; m < 4; ++m) { const int rl = rl0 + ai * 128 + m * 16, r = u.pm * 256 + rl; const float rs = tab[rl];
                if (u.pn < 8) { const float r2 = rs * rs;
                    const f32x4 u0 = acc[ai][0][m][0] * acc[ai][1][m][0] * r2, u1 = acc[ai][0][m][1] * acc[ai][1][m][1] * r2;
                    *(u32x4*)(U + (size_t)r * D + 128 * u.pn + 32 * wc + 8 * fq) = pack8(u0, u1);
                } else {
#pragma unroll
                    for (int bj = 0; bj < 2; ++bj) *(u32x4*)(GB + (size_t)r * D + 256 * (u.pn - 8) + 128 * bj + 32 * wc + 8 * fq) = pack8(acc[ai][bj][m][0] * rs, acc[ai][bj][m][1] * rs);
                } }
    }
};
struct EpiRes { static constexpr bool FINAL = false, PERM = false; const float* Xin; bf16_t* XB; float* ssp;
    typedef PreNone Pre;
    __device__ __forceinline__ Pre prep_load(const pg8::Unit&, int) const { return Pre{}; }
    __device__ __forceinline__ void prep_store(const Pre&, LAS float*, int) const {}
    __device__ __forceinline__ void operator()(const AccT& acc, const pg8::Unit& u, int wr, int wc, int fr, int fq, const LAS float*) const {
        const int row0 = u.pm * 256 + wr * 64 + fr, col0 = u.pn * 256 + wc * 32 + 4 * fq;
#pragma unroll
        for (int ai = 0; ai < 2; ++ai)
            {
                f32x4 xr[4][2][2];
#pragma unroll
                for (int mm = 0; mm < 4; ++mm)
#pragma unroll
                    for (int bj = 0; bj < 2; ++bj)
#pragma unroll
                        for (int n = 0; n < 2; ++n) { const size_t o = (size_t)(row0 + ai * 128 + mm * 16) * D + col0 + bj * 128 + n * 16;
                            if (Xin) xr[mm][bj][n] = __builtin_nontemporal_load((const f32x4*)(Xin + o));
                            else { const u32x2 w = *(const u32x2*)(XB + o); xr[mm][bj][n] = (f32x4){bf_lo(w.x), bf_hi(w.x), bf_lo(w.y), bf_hi(w.y)}; } }
                EPI_FENCE();
#pragma unroll
                for (int mm = 0; mm < 4; ++mm) { const int m = mm, r = row0 + ai * 128 + m * 16; float ss = 0.f;
#pragma unroll
                    for (int bj = 0; bj < 2; ++bj)
#pragma unroll
                        for (int n = 0; n < 2; ++n) { const size_t o = (size_t)r * D + col0 + bj * 128 + n * 16;
                            const f32x4 x = xr[mm][bj][n] + acc[ai][bj][m][n];
                            ss += (x.x * x.x + x.y * x.y) + (x.z * x.z + x.w * x.w);
                            u32x2 w; w.x = cvt_pk_bf16(x.x, x.y); w.y = cvt_pk_bf16(x.z, x.w); *(u32x2*)(XB + o) = w; }
                    { const int ln = fr + 16 * fq; ss += shx(ss, 16, ln); ss += shx(ss, 32, ln); }
                    if (fq == 0) ssp[(size_t)r * 16 + 4 * u.pn + wc] = ss; }
                EPI_FENCE(); }
    }
};
struct EpiFinal { static constexpr bool FINAL = true, PERM = false; const bf16_t* XB; float* out; float* ssp; const float* gfin; unsigned* cnt;
    typedef PreNone Pre;
    __device__ __forceinline__ Pre prep_load(const pg8::Unit&, int) const { return Pre{}; }
    __device__ __forceinline__ void prep_store(const Pre&, LAS float*, int) const {}
    __device__ __forceinline__ void final(AccT& acc, const pg8::Unit& u, int wr, int wc, int fr, int fq, LAS float* tab, int tid, int wid, int lane) const {
        const int row0 = u.pm * 256 + wr * 64 + fr, col0 = u.pn * 256 + wc * 32 + 4 * fq;
#pragma unroll
        for (int ai = 0; ai < 2; ++ai)
            {
                f32x4 xr[4][2][2];
#pragma unroll
                for (int mm = 0; mm < 4; ++mm)
#pragma unroll
                    for (int bj = 0; bj < 2; ++bj)
#pragma unroll
                        for (int n = 0; n < 2; ++n) { const u32x2 w = *(const u32x2*)(XB + (size_t)(row0 + ai * 128 + mm * 16) * D + col0 + bj * 128 + n * 16); xr[mm][bj][n] = (f32x4){bf_lo(w.x), bf_hi(w.x), bf_lo(w.y), bf_hi(w.y)}; }
                EPI_FENCE();
#pragma unroll
                for (int mm = 0; mm < 4; ++mm) { const int m = mm, r = row0 + ai * 128 + m * 16; float ss = 0.f;
#pragma unroll
                    for (int bj = 0; bj < 2; ++bj)
#pragma unroll
                        for (int n = 0; n < 2; ++n) { const f32x4 x = xr[mm][bj][n] + acc[ai][bj][m][n]; acc[ai][bj][m][n] = x; ss += (x.x * x.x + x.y * x.y) + (x.z * x.z + x.w * x.w); }
                    { const int ln = fr + 16 * fq; ss += shx(ss, 16, ln); ss += shx(ss, 32, ln); }
                    if (fq == 0) ssp[(size_t)r * 16 + 4 * u.pn + wc] = ss; }
                EPI_FENCE(); }
        asm volatile("s_waitcnt vmcnt(0)" ::: "memory");
        __builtin_amdgcn_s_barrier();
        asm volatile("" ::: "memory");
        if (wid == 0) {
            unsigned* c = cnt + 64 * u.pm;
            __builtin_amdgcn_fence(__ATOMIC_RELEASE, "agent");
            asm volatile("s_waitcnt vmcnt(0)" ::: "memory");
            if (lane == 0) (void)__hip_atomic_fetch_add(c, 1u, __ATOMIC_RELAXED, __HIP_MEMORY_SCOPE_AGENT);
            unsigned sp = 0;
            while ((unsigned)__builtin_amdgcn_readfirstlane(__hip_atomic_load(c, __ATOMIC_RELAXED, __HIP_MEMORY_SCOPE_AGENT)) < 4u) { __builtin_amdgcn_s_sleep(2); if (++sp > (1u << 22)) break; }
            __builtin_amdgcn_fence(__ATOMIC_ACQUIRE, "agent");
            asm volatile("s_waitcnt vmcnt(0)" ::: "memory");
        }
        __builtin_amdgcn_s_barrier();
        asm volatile("" ::: "memory");
        if (tid < 256) tab[tid] = row_scale(ssp, u.pm * 256 + tid);
        f32x4 gv[2][2];
#pragma unroll
        for (int bj = 0; bj < 2; ++bj)
#pragma unroll
            for (int n = 0; n < 2; ++n) gv[bj][n] = *(const f32x4*)(gfin + col0 + bj * 128 + n * 16);
        asm volatile("s_waitcnt lgkmcnt(0)" ::: "memory");
        __builtin_amdgcn_s_barrier();
        asm volatile("" ::: "memory");
#pragma unroll
        for (int ai = 0; ai < 2; ++ai)
#pragma unroll
            for (int m = 0; m < 4; ++m) { const int rl = wr * 64 + fr + ai * 128 + m * 16; const float rs = tab[rl];
#pragma unroll
                for (int bj = 0; bj < 2; ++bj)
#pragma unroll
                    for (int n = 0; n < 2; ++n) __builtin_nontemporal_store(acc[ai][bj][m][n] * rs * gv[bj][n], (f32x4*)(out + (size_t)(u.pm * 256 + rl) * D + col0 + bj * 128 + n * 16)); }
    }
};
struct EpiUp { static constexpr bool FINAL = false, PERM = true; bf16_t* H; const float* ssp;
    typedef PreSS Pre;
    __device__ __forceinline__ Pre prep_load(const pg8::Unit& u, int tid) const { return ss_load(ssp, u.pm * 256, tid); }
    __device__ __forceinline__ void prep_store(const Pre& p, LAS float* tab, int tid) const { ss_store(p, tab, tid); }
    __device__ __forceinline__ void operator()(const AccT& acc, const pg8::Unit& u, int wr, int wc, int fr, int fq, const LAS float* tab) const {
        const int rl0 = wr * 64 + fr;
#pragma unroll
        for (int ai = 0; ai < 2; ++ai)
#pragma unroll
            for (int m = 0; m < 4; ++m) { const int rl = rl0 + ai * 128 + m * 16, r = u.pm * 256 + rl; const float rs = tab[rl];
#pragma unroll
                for (int bj = 0; bj < 2; ++bj) { f32x4 a = acc[ai][bj][m][0] * rs, b = acc[ai][bj][m][1] * rs;
                    a = __builtin_elementwise_max(a, (f32x4){0.f, 0.f, 0.f, 0.f}); b = __builtin_elementwise_max(b, (f32x4){0.f, 0.f, 0.f, 0.f});
                    store_wt(H + (size_t)r * FF + 256 * u.pn + 128 * bj + 32 * wc + 8 * fq, pack8(a * a, b * b)); } }
    }
};
struct EpiQKG { static constexpr bool FINAL = false, PERM = true; bf16_t* Q; bf16_t* Kb; bf16_t* KF; bf16_t* KW; bf16_t* A3; const float* ssp; const float* rope; int smask;
    typedef PreSS Pre;
    __device__ __forceinline__ Pre prep_load(const pg8::Unit& u, int tid) const { return ss_load(ssp, u.pm * 256, tid); }
    __device__ __forceinline__ void prep_store(const Pre& p, LAS float* tab, int tid) const { ss_store(p, tab, tid); }
    __device__ __forceinline__ void operator()(const AccT& acc, const pg8::Unit& u, int wr, int wc, int fr, int fq, const LAS float* tab) const {
        const int rl0 = wr * 64 + fr;
#pragma unroll
        for (int ai = 0; ai < 2; ++ai)
#pragma unroll
            for (int m = 0; m < 4; ++m) { const int rl = rl0 + ai * 128 + m * 16, r = u.pm * 256 + rl; const float rs = tab[rl];
                if (u.pn < 8) {
                    const int c = 32 * wc + 8 * fq; const float sc = (u.pn < 4) ? rs * 0.0625f : rs;
                    const f32x4* tp = (const f32x4*)(rope + ((size_t)(r & smask) * 128 + c) * 2);
                    const f32x4 t0 = tp[0], t1 = tp[1], t2 = tp[2], t3 = tp[3];
                    const f32x4 x1a = acc[ai][0][m][0] * sc, x1b = acc[ai][0][m][1] * sc, x2a = acc[ai][1][m][0] * sc, x2b = acc[ai][1][m][1] * sc;
                    const f32x4 ca = {t0.x, t0.z, t1.x, t1.z}, sa = {t0.y, t0.w, t1.y, t1.w}, cb = {t2.x, t2.z, t3.x, t3.z}, sb = {t2.y, t2.w, t3.y, t3.w};
                    const f32x4 o1a = x1a * ca - x2a * sa, o1b = x1b * cb - x2b * sb, o2a = x1a * sa + x2a * ca, o2b = x1b * sb + x2b * cb;
                    bf16_t* dst = ((u.pn < 4) ? Q : Kb) + (size_t)r * 1024 + 256 * (u.pn & 3) + c;
                    *(u32x4*)(dst) = pack8(o1a, o1b); *(u32x4*)(dst + 128) = pack8(o2a, o2b);
                    if (u.pn >= 4) { const int hh = u.pn & 3, tt = r & 511; const size_t ko = (size_t)r * 1024 + 256 * hh + c;
                        const float wf = __builtin_amdgcn_exp2f(lg_f(hh) * (float)(511 - tt)), wb = __builtin_amdgcn_exp2f(lg_b(hh) * (float)tt);
                        *(u32x4*)(KF + ko) = pack8(o1a * wf, o1b * wf); *(u32x4*)(KF + ko + 128) = pack8(o2a * wf, o2b * wf);
                        *(u32x4*)(KW + ko) = pack8(o1a * wb, o1b * wb); *(u32x4*)(KW + ko + 128) = pack8(o2a * wb, o2b * wb); }
                    if (m == 3) EPI_FENCE();
                } else {
#pragma unroll
                    for (int bj = 0; bj < 2; ++bj) { f32x4 a = acc[ai][bj][m][0] * rs, b = acc[ai][bj][m][1] * rs;
#pragma unroll
                        for (int i = 0; i < 4; ++i) { a[i] = a[i] * __builtin_amdgcn_rcpf(1.0f + __builtin_amdgcn_exp2f(-1.44269504f * a[i])); b[i] = b[i] * __builtin_amdgcn_rcpf(1.0f + __builtin_amdgcn_exp2f(-1.44269504f * b[i])); }
                        *(u32x4*)(A3 + (size_t)r * DVW + 256 * (u.pn - 8) + 128 * bj + 32 * wc + 8 * fq) = pack8(a, b); }
                } }
    }
};
struct EpiVT { static constexpr bool FINAL = false, PERM = true; bf16_t* VT; const float* ssp;
    typedef PreSS Pre;
    __device__ __forceinline__ Pre prep_load(const pg8::Unit& u, int tid) const { return ss_load(ssp, u.pn * 256, tid); }
    __device__ __forceinline__ void prep_store(const Pre& p, LAS float* tab, int tid) const { ss_store(p, tab, tid); }
    __device__ __forceinline__ void operator()(const AccT& acc, const pg8::Unit& u, int wr, int wc, int fr, int fq, const LAS float* tab) const {
        const int row0 = u.pm * 256 + wr * 64 + fr, cl0 = 32 * wc + 8 * fq, col0 = u.pn * 256 + cl0;
        f32x4 s[2][2];
#pragma unroll
        for (int bj = 0; bj < 2; ++bj)
#pragma unroll
            for (int n = 0; n < 2; ++n) s[bj][n] = *(const LAS f32x4*)(tab + cl0 + 128 * bj + 4 * n);
#pragma unroll
        for (int ai = 0; ai < 2; ++ai)
#pragma unroll
            for (int m = 0; m < 4; ++m) { const int r = row0 + ai * 128 + m * 16;
#pragma unroll
                for (int bj = 0; bj < 2; ++bj) *(u32x4*)(VT + (size_t)r * SLAB + col0 + 128 * bj) = pack8(acc[ai][bj][m][0] * s[bj][0], acc[ai][bj][m][1] * s[bj][1]); }
    }
};

struct QkvOrder { pg8::StaticOrder<SLAB, 4096> s0; pg8::StaticOrder<DVW, SLAB> s1;
    __device__ __forceinline__ void init(int G_, int c_) { s0.init(G_, c_); s1.init(G_, c_); }
    __device__ __forceinline__ bool next(int i, pg8::Unit& u) const { if (i < 2) return s0.next(i, u); const bool ok = s1.next(i - 2, u); u.ty = 1; return ok; }
};
struct EpiQKVG { static constexpr bool FINAL = false, PERM = true; EpiQKG a; EpiVT b;
    typedef PreSS Pre;
    __device__ __forceinline__ Pre prep_load(const pg8::Unit& u, int tid) const { return u.ty ? b.prep_load(u, tid) : a.prep_load(u, tid); }
    __device__ __forceinline__ void prep_store(const Pre& p, LAS float* tab, int tid) const { ss_store(p, tab, tid); }
    __device__ __forceinline__ void operator()(const AccT& acc, const pg8::Unit& u, int wr, int wc, int fr, int fq, const LAS float* tab) const { if (u.ty) b(acc, u, wr, wc, fr, fq, tab); else a(acc, u, wr, wc, fr, fq, tab); }
};

__device__ __forceinline__ float wave_sum(float v, int lane) {
#pragma unroll
    for (int o = 1; o < 64; o <<= 1) v += shx(v, o, lane);
    return v;
}
template <bool NTS = false>
__device__ __forceinline__ void transpose_item(const float* W, int K, int N, const float* gain, bf16_t* WT, int drow0, int scol0, int k0, LAS float* scr, int lane) {
    f32x4 v[8];
#pragma unroll
    for (int i = 0; i < 8; ++i) { const int kk = 8 * i + (lane >> 3); v[i] = __builtin_nontemporal_load((const f32x4*)(W + (size_t)(k0 + kk) * N + scol0 + 4 * (lane & 7))); }
#pragma unroll
    for (int i = 0; i < 8; ++i) { const int kk = 8 * i + (lane >> 3); const float gv = gain ? gain[k0 + kk] : 1.0f; LAS float* d = scr + kk * 33 + 4 * (lane & 7);
        d[0] = v[i].x * gv; d[1] = v[i].y * gv; d[2] = v[i].z * gv; d[3] = v[i].w * gv; }
    asm volatile("s_waitcnt lgkmcnt(0)" ::: "memory");
    const int c = lane & 7;
#pragma unroll
    for (int j = 0; j < 4; ++j) { const int n = (lane >> 3) + 8 * j; const LAS float* s = scr + (8 * c) * 33 + n;
        u32x4 o; o.x = cvt_pk_bf16(s[0 * 33], s[1 * 33]); o.y = cvt_pk_bf16(s[2 * 33], s[3 * 33]); o.z = cvt_pk_bf16(s[4 * 33], s[5 * 33]); o.w = cvt_pk_bf16(s[6 * 33], s[7 * 33]);
        if (NTS) __builtin_nontemporal_store(o, (u32x4*)(WT + (size_t)(drow0 + n) * K + k0 + 8 * c)); else *(u32x4*)(WT + (size_t)(drow0 + n) * K + k0 + 8 * c) = o; }
    asm volatile("s_waitcnt lgkmcnt(0)" ::: "memory");
}
__device__ __forceinline__ void xb_prep(const float* x, bf16_t* XB, float* ssp, int gw, int ngw, int lane, int nrows = MG) {
    for (int r = gw; r < nrows; r += 2 * ngw) {
        const int r2 = r + ngw;
        const f32x4* xa = (const f32x4*)(x + (size_t)r * D) + lane; const f32x4* xb = (const f32x4*)(x + (size_t)r2 * D) + lane;
        f32x4 va[4], vb[4];
#pragma unroll
        for (int j = 0; j < 4; ++j) { va[j] = __builtin_nontemporal_load(xa + 64 * j); vb[j] = __builtin_nontemporal_load(xb + 64 * j); }
        unsigned long long* oa = (unsigned long long*)(XB + (size_t)r * D) + lane; unsigned long long* ob = (unsigned long long*)(XB + (size_t)r2 * D) + lane;
        float sa = 0.f, sb2 = 0.f;
#pragma unroll
        for (int j = 0; j < 4; ++j) { const f32x4 v = va[j], w = vb[j];
            sa += (v.x * v.x + v.y * v.y) + (v.z * v.z + v.w * v.w); sb2 += (w.x * w.x + w.y * w.y) + (w.z * w.z + w.w * w.w);
            oa[64 * j] = (unsigned long long)cvt_pk_bf16(v.x, v.y) | ((unsigned long long)cvt_pk_bf16(v.z, v.w) << 32);
            ob[64 * j] = (unsigned long long)cvt_pk_bf16(w.x, w.y) | ((unsigned long long)cvt_pk_bf16(w.z, w.w) << 32); }
#pragma unroll
        for (int o = 1; o < 64; o <<= 1) { sa += shx(sa, o, lane); sb2 += shx(sb2, o, lane); }
        if (lane < 16) { ssp[(size_t)r * 16 + lane] = (lane == 0) ? sa : 0.f; ssp[(size_t)r2 * 16 + lane] = (lane == 0) ? sb2 : 0.f; }
    }
}
__device__ __forceinline__ void rope_entry(float* rope, int idx) {
    const int pos = idx >> 7, c = idx & 127;
    const float inv = (float)exp2(-(double)c * (13.287712379549449 / 128.0));
    const float angf = (float)pos * inv;
    const double ang = (double)angf;
    const double kq = rint(ang * 0.63661977236758134308);
    double r = fma(-kq, 1.57079632679489655800e+00, ang); r = fma(-kq, 6.12323399573676603587e-17, r);
    const double r2 = r * r;
    double sn = 1.0 / 6227020800.0; sn = fma(sn, r2, -1.0 / 39916800.0); sn = fma(sn, r2, 1.0 / 362880.0); sn = fma(sn, r2, -1.0 / 5040.0); sn = fma(sn, r2, 1.0 / 120.0); sn = fma(sn, r2, -1.0 / 6.0); sn = fma(sn * r2, r, r);
    double cs = 1.0 / 479001600.0; cs = fma(cs, r2, -1.0 / 3628800.0); cs = fma(cs, r2, 1.0 / 40320.0); cs = fma(cs, r2, -1.0 / 720.0); cs = fma(cs, r2, 1.0 / 24.0); cs = fma(cs, r2, -0.5); cs = fma(cs, r2, 1.0);
    const int q = ((int)kq) & 3;
    const double c0 = (q == 0) ? cs : (q == 1) ? -sn : (q == 2) ? -cs : sn;
    const double s0 = (q == 0) ? sn : (q == 1) ? cs : (q == 2) ? -sn : -cs;
    *(f32x2*)(rope + (size_t)idx * 2) = (f32x2){(float)c0, (float)s0};
}

constexpr int BLK = 512;
__device__ __forceinline__ unsigned offb(unsigned row, unsigned ch) { return 256u * row + 16u * (ch ^ (((row & 3u) << 2) | ((row >> 2) & 3u))); }
__device__ __forceinline__ bf16x8 scale8s(bf16x8 v, float w) {
    const u32x4 x = __builtin_bit_cast(u32x4, v); u32x4 o;
    o.x = cvt_pk_bf16(bf_lo(x.x) * w, bf_hi(x.x) * w); o.y = cvt_pk_bf16(bf_lo(x.y) * w, bf_hi(x.y) * w);
    o.z = cvt_pk_bf16(bf_lo(x.z) * w, bf_hi(x.z) * w); o.w = cvt_pk_bf16(bf_lo(x.w) * w, bf_hi(x.w) * w);
    return __builtin_bit_cast(bf16x8, o);
}

__device__ __forceinline__ void chain_phase(LAS unsigned char* lds, const bf16_t* KF, const bf16_t* KW, const bf16_t* VT, bf16_t* ST, int S, int nseq) {
    int tid_ = threadIdx.x; asm volatile("" : "+v"(tid_));
    const int tid = tid_, wid = __builtin_amdgcn_readfirstlane(tid >> 6), lane = tid & 63, fr = lane & 15, fq = lane >> 4, wa = wid >> 1, wb = wid & 1;
    const unsigned ldsb = (unsigned)(size_t)lds;
    const int fragoff = (fr * 64 + fq * 16) ^ (((fr >> 3) & 1) << 5);
    const int sb = lane * 16, swz = sb ^ (((sb >> 9) & 1) << 5), dR = swz >> 6, dC = (swz & 63) >> 1;
    const int N = S / BLK, nst = (S - BLK) / 64;
    unsigned tra[2][2];
    { const unsigned q = (lane & 15) >> 2, p = lane & 3;
#pragma unroll
      for (int i = 0; i < 2; ++i)
#pragma unroll
          for (int t = 0; t < 2; ++t) tra[i][t] = offb(8u * fq + 4u * t + q, 2u * (2 * wa + i) + (p >> 1)) + 8u * (p & 1); }
    const int sub = blockIdx.x >> 3, pr = (int)(blockIdx.x & 7) + 8 * (sub >> 4);
    if (sub < 32 && pr < nseq * 4) {
        const int s4 = sub & 15, dvq = s4 & 3, dkh = (s4 >> 2) & 1, dir = s4 >> 3, h = pr & 3, sq = pr >> 2;
        const int seq0 = sq * S;
        const float lg = dir ? lg_b(h) : lg_f(h);
        const float d512 = __builtin_amdgcn_exp2f(lg * 512.0f);
        f32x4 acc[2][4];
#pragma unroll
        for (int i = 0; i < 2; ++i)
#pragma unroll
            for (int j = 0; j < 4; ++j) acc[i][j] = (f32x4){0.f, 0.f, 0.f, 0.f};
        const bf16_t* kg[2]; const bf16_t* vg[2];
#pragma unroll
        for (int jj = 0; jj < 2; ++jj) { const int p = 2 * wid + jj, row = 4 * (p & 7) + (lane >> 4), ch = (lane & 15) ^ (((row & 3) << 2) | ((row >> 2) & 3));
            kg[jj] = (dir ? KW : KF) + (size_t)(seq0 + 32 * (p >> 3) + row) * 1024 + 256 * h + 128 * dkh + 8 * ch;
            vg[jj] = VT + (size_t)(512 * h + 128 * dvq + 16 * (p >> 1) + dR) * SLAB + seq0 + 32 * (p & 1) + dC; }
        bf16_t* stbase = ST + ((size_t)(((sq * 4 + h) * 2 + dir) * (N - 1)) << 17) + (size_t)(128 * dvq + 64 * wb + fr) * 256 + 128 * dkh + 32 * wa + 4 * fq;
#define CH_DMA(u_) do { const int _u = (u_) < nst ? (u_) : nst - 1; const int _tb = dir ? (S - 64 * (_u + 1)) : 64 * _u; LAS unsigned char* _d = lds + ((u_) & 3) * 32768; \
        __builtin_amdgcn_global_load_lds((const unsigned*)(kg[0] + (size_t)_tb * 1024), (LAS unsigned*)(_d + (2 * wid) * 1024), 16, 0, 0); \
        __builtin_amdgcn_global_load_lds((const unsigned*)(kg[1] + (size_t)_tb * 1024), (LAS unsigned*)(_d + (2 * wid + 1) * 1024), 16, 0, 0); \
        __builtin_amdgcn_global_load_lds((const unsigned*)(vg[0] + _tb), (LAS unsigned*)(_d + 16384 + (2 * wid) * 1024), 16, 0, 0); \
        __builtin_amdgcn_global_load_lds((const unsigned*)(vg[1] + _tb), (LAS unsigned*)(_d + 16384 + (2 * wid + 1) * 1024), 16, 0, 0); } while (0)
        CH_DMA(0); CH_DMA(1); CH_DMA(2);
#pragma unroll 1
        for (int u = 0; u < nst; ++u) {
            asm volatile("s_waitcnt vmcnt(8)" ::: "memory");
            __builtin_amdgcn_s_barrier();
            asm volatile("" ::: "memory");
            CH_DMA(u + 3);
            LAS unsigned char* stg = lds + (u & 3) * 32768;
            {
                const unsigned kimg = ldsb + (u & 3) * 32768;
                bf16x8 v0[4], v1[4];
#pragma unroll
                for (int j = 0; j < 4; ++j) { v0[j] = *(const LAS bf16x8*)(stg + 16384 + ((4 * wb + j) * 2 + 0) * 1024 + fragoff); v1[j] = *(const LAS bf16x8*)(stg + 16384 + ((4 * wb + j) * 2 + 1) * 1024 + fragoff); }
                u32x2 a00, a01, a10, a11, b00, b01, b10, b11;
                asm volatile("ds_read_b64_tr_b16 %0, %8\n\tds_read_b64_tr_b16 %1, %9\n\tds_read_b64_tr_b16 %2, %10\n\tds_read_b64_tr_b16 %3, %11\n\t"
                             "ds_read_b64_tr_b16 %4, %8 offset:8192\n\tds_read_b64_tr_b16 %5, %9 offset:8192\n\tds_read_b64_tr_b16 %6, %10 offset:8192\n\tds_read_b64_tr_b16 %7, %11 offset:8192\n\ts_waitcnt lgkmcnt(0)"
                             : "=&v"(a00), "=&v"(a01), "=&v"(a10), "=&v"(a11), "=&v"(b00), "=&v"(b01), "=&v"(b10), "=&v"(b11)
                             : "v"(kimg + tra[0][0]), "v"(kimg + tra[0][1]), "v"(kimg + tra[1][0]), "v"(kimg + tra[1][1]) : "memory");
                const bf16x8 A0 = __builtin_bit_cast(bf16x8, (u32x4){a00.x, a00.y, a01.x, a01.y}), A1 = __builtin_bit_cast(bf16x8, (u32x4){a10.x, a10.y, a11.x, a11.y});
                const bf16x8 B0 = __builtin_bit_cast(bf16x8, (u32x4){b00.x, b00.y, b01.x, b01.y}), B1 = __builtin_bit_cast(bf16x8, (u32x4){b10.x, b10.y, b11.x, b11.y});
                __builtin_amdgcn_s_setprio(1);
#pragma unroll
                for (int j = 0; j < 4; ++j) { acc[0][j] = __builtin_amdgcn_mfma_f32_16x16x32_bf16(A0, v0[j], acc[0][j], 0, 0, 0); acc[1][j] = __builtin_amdgcn_mfma_f32_16x16x32_bf16(A1, v0[j], acc[1][j], 0, 0, 0); }
#pragma unroll
                for (int j = 0; j < 4; ++j) { acc[0][j] = __builtin_amdgcn_mfma_f32_16x16x32_bf16(B0, v1[j], acc[0][j], 0, 0, 0); acc[1][j] = __builtin_amdgcn_mfma_f32_16x16x32_bf16(B1, v1[j], acc[1][j], 0, 0, 0); }
                __builtin_amdgcn_s_setprio(0);
            }
            if (((u + 1) & 7) == 0) {
                const int kb = (u + 1) >> 3, slot = dir ? (N - 1 - kb) : (kb - 1);
                bf16_t* sp = stbase + ((size_t)slot << 17);
#pragma unroll
                for (int i = 0; i < 2; ++i)
#pragma unroll
                    for (int j = 0; j < 4; ++j) { const f32x4 sv = acc[i][j]; u32x2 w; w.x = f2bf_rne(sv.x) | (f2bf_rne(sv.y) << 16); w.y = f2bf_rne(sv.z) | (f2bf_rne(sv.w) << 16);
                        *(u32x2*)(sp + (size_t)(16 * j) * 256 + 16 * i) = w; }
#pragma unroll
                for (int i = 0; i < 2; ++i)
#pragma unroll
                    for (int j = 0; j < 4; ++j) acc[i][j] = acc[i][j] * d512;
            }
        }
#undef CH_DMA
        asm volatile("s_waitcnt vmcnt(0) lgkmcnt(0)" ::: "memory");
        __builtin_amdgcn_s_barrier();
        asm volatile("" ::: "memory");
    }
}

__device__ __forceinline__ void retention_phase(LAS unsigned char* lds, const bf16_t* Q, const bf16_t* Kb, const bf16_t* VT, const bf16_t* ST, bf16_t* A3s  , int S) {
    const int N = S / BLK;
    for (int item = blockIdx.x; item < (SLAB / 128) * 4; item += gridDim.x) {
        int tid_ = threadIdx.x; asm volatile("" : "+v"(tid_));
        const int tid = tid_, wid = __builtin_amdgcn_readfirstlane(tid >> 6), lane = tid & 63, wr = wid >> 2, wc = wid & 3, fr = lane & 15, fq = lane >> 4;
        const int fragoff = (fr * 64 + fq * 16) ^ (((fr >> 3) & 1) << 5);
        const int sb = lane * 16, swz = sb ^ (((sb >> 9) & 1) << 5), dR = swz >> 6, dC = (swz & 63) >> 1;
        LAS f32x2* RED = (LAS f32x2*)(lds);
        const int qpp = S / 128  , jj = item >> 3, pr = (item & 7) + 8 * (jj / qpp), qb = jj % qpp;
        const int h = pr & 3, sq = pr >> 2, seq0 = sq * S, row0 = seq0 + 128 * qb, qpos0 = 128 * qb, n = qpos0 / BLK, blk0 = seq0 + BLK * n;
        const float lf = lg_f(h), lb = lg_b(h);
        const int nF = (n > 0) ? 8 : 0, nB = (n < N - 1) ? 8 : 0, nsteps = 16 + nF + nB;
        bf16x8 qa[8];
        { const bf16_t* qp = Q + (size_t)(row0 + 16 * wid + fr) * 1024 + 256 * h + 8 * fq;
#pragma unroll
          for (int s = 0; s < 8; ++s) qa[s] = *(const bf16x8*)(qp + 32 * s); }
        f32x4 acc[4][8];
#pragma unroll
        for (int a = 0; a < 4; ++a)
#pragma unroll
            for (int b = 0; b < 8; ++b) acc[a][b] = (f32x4){0.f, 0.f, 0.f, 0.f};
        const bf16_t* kbase = Kb + (size_t)blk0 * 1024 + 256 * h;
        const bf16_t* vbase = VT + (size_t)(512 * h) * SLAB + blk0;
        const bf16_t* fbase = ST + ((size_t)(((sq * 4 + h) * 2 + 0) * (N - 1) + (n - 1)) << 17);
        const bf16_t* bbase = ST + ((size_t)(((sq * 4 + h) * 2 + 1) * (N - 1) + n) << 17);
        const unsigned lok = (unsigned)(dR * 1024 + dC) * 2u, lov = (unsigned)(dR * SLAB + dC) * 2u, los = (unsigned)(dR * 256 + dC) * 2u;
#define RT_ISSUE(st_) do { const int _b = (st_) % 3, _e = ((st_) < nsteps) ? (st_) : 0, _kt = (_e < 16) ? _e : 0; \
        _Pragma("unroll") for (int _j = 0; _j < 2; ++_j) { const int _st = 2 * wid + _j; \
            __builtin_amdgcn_global_load_lds((const unsigned*)((const char*)(kbase + (size_t)(32 * _kt + 16 * (_st >> 3)) * 1024 + 32 * (_st & 7)) + lok), (LAS unsigned*)(lds + _b * 16384 + _st * 1024), 16, 0, 0); } \
        if (_e < 16) { \
            _Pragma("unroll") for (int _j = 0; _j < 4; ++_j) { const int _st = 4 * wid + _j; \
                __builtin_amdgcn_global_load_lds((const unsigned*)((const char*)(vbase + (size_t)(16 * _st) * SLAB + 32 * _e) + lov), (LAS unsigned*)(lds + 49152 + _b * 32768 + _st * 1024), 16, 0, 0); } \
        } else { const bf16_t* _sb = (_e < 16 + nF) ? fbase + 32 * (_e - 16) : bbase + 32 * (_e - 16 - nF); \
            _Pragma("unroll") for (int _j = 0; _j < 4; ++_j) { const int _st = 4 * wid + _j; \
                __builtin_amdgcn_global_load_lds((const unsigned*)((const char*)(_sb + (size_t)(16 * _st) * 256) + los), (LAS unsigned*)(lds + 49152 + _b * 32768 + _st * 1024), 16, 0, 0); } } } while (0)
        const int qib = (qpos0 & (BLK - 1)) + 16 * wid + fr;
        const float df = __builtin_amdgcn_exp2f(lf * (float)(qib + 1)), db = __builtin_amdgcn_exp2f(lb * (float)(BLK - qib));
        asm volatile("s_waitcnt vmcnt(0)" ::: "memory");
        RT_ISSUE(0); RT_ISSUE(1);
#pragma unroll 1
        for (int st = 0; st < nsteps; ++st) {
            const int b = st % 3;
            asm volatile("s_waitcnt vmcnt(6)" ::: "memory");
            __builtin_amdgcn_s_barrier();
            asm volatile("" ::: "memory");
            RT_ISSUE(st + 2);
            LAS unsigned char* ps = lds + 147456;
            if (st < 16) {
                LAS unsigned char* ks = lds + b * 16384 + fragoff;
                {
                    f32x4 p0 = {0.f, 0.f, 0.f, 0.f}, p1 = {0.f, 0.f, 0.f, 0.f}; bf16x8 ka[4], kb[4];
#define RT_LDK(dst, t2_, s0_) do { _Pragma("unroll") for (int s = 0; s < 4; ++s) dst[s] = *(const LAS bf16x8*)(ks + ((t2_) * 8 + (s0_) + s) * 1024); } while (0)
#define RT_MMK(pp, src_, s0_) do { _Pragma("unroll") for (int s = 0; s < 4; ++s) pp = __builtin_amdgcn_mfma_f32_16x16x32_bf16(src_[s], qa[(s0_) + s], pp, 0, 0, 0); } while (0)
                    RT_LDK(ka, 0, 0); RT_LDK(kb, 0, 4); __builtin_amdgcn_sched_barrier(0);
                    __builtin_amdgcn_s_setprio(1);
                    RT_MMK(p0, ka, 0); RT_LDK(ka, 1, 0); __builtin_amdgcn_sched_barrier(0);
                    RT_MMK(p0, kb, 4); RT_LDK(kb, 1, 4); __builtin_amdgcn_sched_barrier(0);
                    RT_MMK(p1, ka, 0); RT_MMK(p1, kb, 4);
                    __builtin_amdgcn_s_setprio(0);
#undef RT_LDK
#undef RT_MMK
#pragma unroll
                    for (int t2 = 0; t2 < 2; ++t2) { f32x4 p = t2 ? p1 : p0;
                        const int dd = qib - (32 * st + 16 * t2 + 4 * fq);
#pragma unroll
                        for (int i = 0; i < 4; ++i) { const int d = dd - i; const float e = (d >= 0) ? lf * (float)d : lb * (float)(-d); p[i] *= __builtin_amdgcn_exp2f(e); }
                        const int ob = fr * 64 + (16 * t2 + 4 * fq) * 2;
                        u32x2 w; w.x = cvt_pk_bf16(p[0], p[1]); w.y = cvt_pk_bf16(p[2], p[3]);
                        *(LAS u32x2*)(ps + wid * 1024 + (ob ^ (((ob >> 9) & 1) << 5))) = w; }
                }
            } else {
                bf16x8 qv;
                switch (st & 7) { case 0: qv = qa[0]; break; case 1: qv = qa[1]; break; case 2: qv = qa[2]; break; case 3: qv = qa[3]; break;
                                  case 4: qv = qa[4]; break; case 5: qv = qa[5]; break; case 6: qv = qa[6]; break; default: qv = qa[7]; break; }
                *(LAS bf16x8*)(ps + wid * 1024 + fragoff) = scale8s(qv, (st < 16 + nF) ? df : db);
            }
            asm volatile("s_waitcnt lgkmcnt(0)" ::: "memory");
            __builtin_amdgcn_s_barrier();
            asm volatile("" ::: "memory");
            {
                bf16x8 pf[4], va[4], vb[4];
#pragma unroll
                for (int mt = 0; mt < 4; ++mt) pf[mt] = *(const LAS bf16x8*)(ps + (4 * wr + mt) * 1024 + fragoff);
#pragma unroll
                for (int nt2 = 0; nt2 < 4; ++nt2) va[nt2] = *(const LAS bf16x8*)(lds + 49152 + b * 32768 + (8 * wc + nt2) * 1024 + fragoff);
                __builtin_amdgcn_sched_barrier(0);
                __builtin_amdgcn_s_setprio(1);
#pragma unroll
                for (int nt2 = 0; nt2 < 4; ++nt2) vb[nt2] = *(const LAS bf16x8*)(lds + 49152 + b * 32768 + (8 * wc + 4 + nt2) * 1024 + fragoff);
#pragma unroll
                for (int nt2 = 0; nt2 < 4; ++nt2)
#pragma unroll
                    for (int mt = 0; mt < 4; ++mt) acc[mt][nt2] = __builtin_amdgcn_mfma_f32_16x16x32_bf16(va[nt2], pf[mt], acc[mt][nt2], 0, 0, 0);
                __builtin_amdgcn_sched_group_barrier(0x8, 1, 0); __builtin_amdgcn_sched_group_barrier(0x100, 4, 0); __builtin_amdgcn_sched_group_barrier(0x8, 15, 0);
                __builtin_amdgcn_sched_barrier(0);
#pragma unroll
                for (int nt2 = 0; nt2 < 4; ++nt2)
#pragma unroll
                    for (int mt = 0; mt < 4; ++mt) acc[mt][4 + nt2] = __builtin_amdgcn_mfma_f32_16x16x32_bf16(vb[nt2], pf[mt], acc[mt][4 + nt2], 0, 0, 0);
                __builtin_amdgcn_sched_barrier(0);
                __builtin_amdgcn_s_setprio(0);
            }
        }
#undef RT_ISSUE
        asm volatile("s_waitcnt vmcnt(0)" ::: "memory");
        __builtin_amdgcn_s_barrier();
        asm volatile("" ::: "memory");
        int fr_e = fr, fq_e = fq; asm volatile("" : "+v"(fr_e), "+v"(fq_e));
#pragma unroll
        for (int mt = 0; mt < 4; ++mt) { float s1 = 0.f, s2 = 0.f;
#pragma unroll
            for (int nt2 = 0; nt2 < 8; ++nt2) { const f32x4 v = acc[mt][nt2]; s1 += (v.x + v.y) + (v.z + v.w); s2 += (v.x * v.x + v.y * v.y) + (v.z * v.z + v.w * v.w); }
            { const int ln = fr_e + 16 * fq_e; s1 += shx(s1, 16, ln); s1 += shx(s1, 32, ln); s2 += shx(s2, 16, ln); s2 += shx(s2, 32, ln); }
            if (fq_e == 0) RED[(64 * wr + 16 * mt + fr_e) * 4 + wc] = (f32x2){s1, s2}; }
        asm volatile("s_waitcnt lgkmcnt(0)" ::: "memory");
        __builtin_amdgcn_s_barrier();
        asm volatile("" ::: "memory");
#pragma unroll
        for (int mt = 0; mt < 4; ++mt) { const int row = 64 * wr + 16 * mt + fr_e;
            const f32x2 a = RED[row * 4 + 0], b2 = RED[row * 4 + 1], c2 = RED[row * 4 + 2], d2 = RED[row * 4 + 3];
            const float mean = ((a.x + b2.x) + (c2.x + d2.x)) * (1.0f / 512.0f);
            float var = ((a.y + b2.y) + (c2.y + d2.y)) * (1.0f / 512.0f) - mean * mean; var = var > 0.f ? var : 0.f;
            const float rstd = __builtin_amdgcn_rsqf(var + EPS);
            bf16_t* gp = A3s + (size_t)(row0 + row) * DVW + 512 * h + 128 * wc + 4 * fq_e;
            u32x2 gwv[8];
#pragma unroll
            for (int nt2 = 0; nt2 < 8; ++nt2) gwv[nt2] = *(const u32x2*)(gp + 16 * nt2);
            EPI_FENCE();
#pragma unroll
            for (int nt2 = 0; nt2 < 8; ++nt2) { const u32x2 gw = gwv[nt2]; const f32x4 v = acc[mt][nt2];
                u32x2 w; w.x = cvt_pk_bf16((v.x - mean) * rstd * bf_lo(gw.x), (v.y - mean) * rstd * bf_hi(gw.x)); w.y = cvt_pk_bf16((v.z - mean) * rstd * bf_lo(gw.y), (v.w - mean) * rstd * bf_hi(gw.y));
                *(u32x2*)(gp + 16 * nt2) = w; }
            EPI_FENCE(); }
        asm volatile("s_waitcnt lgkmcnt(0)" ::: "memory");
        __builtin_amdgcn_s_barrier();
        asm volatile("" ::: "memory");
    }
}

struct Args { const float* in[17]; float* out; unsigned char* ws; };
typedef const __attribute__((address_space(4))) Args* ArgsP;
__device__ __forceinline__ ArgsP largs() { ArgsP p = (ArgsP)__builtin_amdgcn_kernarg_segment_ptr(); asm volatile("" : "+s"(p)); return p; }
#define WSB(off) ((bf16_t*)(ws + (off)))

__global__ void __launch_bounds__(512, 2) mega_fwd(Args a_unused) {
    extern __shared__ __attribute__((aligned(16))) unsigned char lds_raw[];
    LAS unsigned char* lds = (LAS unsigned char*)lds_raw;
    const int G = gridDim.x, bx = blockIdx.x;
#define PH_IDS() int tid = threadIdx.x; asm volatile("" : "+v"(tid)); const int lane = tid & 63, wave = __builtin_amdgcn_readfirstlane(tid >> 6), gw = bx * 8 + wave, ngw = G * 8; (void)lane; (void)gw; (void)ngw
    { const int tid = threadIdx.x;
      volatile LAS unsigned* MISC = (volatile LAS unsigned*)(lds + MISC_OFF); if (tid < 32) MISC[tid] = 0u; }
    __syncthreads();
    XcdBarrier bar = xcd_barrier_post((unsigned*)(largs()->ws + WS_CTL) + CW_BAR, (volatile LAS unsigned*)(lds + MISC_OFF) + 8);
#define GRID_BAR() xcd_barrier(bar)

    {
        PH_IDS(); ArgsP a = largs(); unsigned char* ws = a->ws;
        LAS float* scr = (LAS float*)(lds + wave * 16384);
        constexpr int I_WIN = 96 * 16, I_WOUT = 32 * 16, I_UP = 128 * 16, I_DN = 32 * 64, I_QKG = 128 * 16, I_V = 64 * 16, I_O = 32 * 32;
        constexpr int NITEMS = I_WIN + I_WOUT + 2 * I_UP + 2 * I_DN + I_QKG + I_V + I_O;
        const int nit = (G > 128) ? NITEMS - (I_O + I_UP + I_DN) : NITEMS;
        for (int it = gw; it < nit; it += ngw) {
            int r = it;
            if (r < I_WIN) { const int nb = r % 96, kb = r / 96, n0 = 32 * nb, pn = n0 >> 8, j = n0 & 255;
                const int src = (pn < 8) ? ((j >> 7) ? 2048 : 0) + 128 * pn + (j & 127) : 1024 + (n0 - 2048);
                transpose_item(a->in[3], 1024, 3072, a->in[2], WSB(WS_WIN), n0, src, 64 * kb, scr, lane); continue; } r -= I_WIN;
            if (r < I_WOUT) { const int nb = r % 32, kb = r / 32; transpose_item(a->in[6], 1024, 1024, nullptr, WSB(WS_WOUT), 32 * nb, 32 * nb, 64 * kb, scr, lane); continue; } r -= I_WOUT;
            if (r < I_UP) { const int nb = r % 128, kb = r / 128; transpose_item(a->in[8], 1024, 4096, a->in[7], WSB(WS_WUP0), 32 * nb, 32 * nb, 64 * kb, scr, lane); continue; } r -= I_UP;
            if (r < I_DN) { const int nb = r % 32, kb = r / 32; transpose_item(a->in[9], 4096, 1024, nullptr, WSB(WS_WDN0), 32 * nb, 32 * nb, 64 * kb, scr, lane); continue; } r -= I_DN;
            if (r < I_QKG) { const int nb = r % 128, kb = r / 128, n0 = 32 * nb; transpose_item(a->in[11], 1024, 6144, a->in[10], WSB(WS_WQKG), n0, n0 < 2048 ? n0 : n0 + 2048, 64 * kb, scr, lane); continue; } r -= I_QKG;
            if (r < I_V) { const int nb = r % 64, kb = r / 64; transpose_item(a->in[11], 1024, 6144, a->in[10], WSB(WS_WV), 32 * nb, 2048 + 32 * nb, 64 * kb, scr, lane); continue; } r -= I_V;
            if (r < I_O) { const int nb = r % 32, kb = r / 32; transpose_item(a->in[12], 2048, 1024, nullptr, WSB(WS_WO), 32 * nb, 32 * nb, 64 * kb, scr, lane); continue; } r -= I_O;
            if (r < I_UP) { const int nb = r % 128, kb = r / 128; transpose_item(a->in[14], 1024, 4096, a->in[13], WSB(WS_WUP1), 32 * nb, 32 * nb, 64 * kb, scr, lane); continue; } r -= I_UP;
            { const int nb = r % 32, kb = r / 32; transpose_item(a->in[15], 4096, 1024, nullptr, WSB(WS_WDN1), 32 * nb, 32 * nb, 64 * kb, scr, lane); }
        }
        float* rope = (float*)(ws + WS_ROPE);
        for (int idx = bx * 512 + tid; idx < 4096 * 128; idx += G * 512) rope_entry(rope, idx);
        xb_prep(a->in[0], WSB(WS_XB), (float*)(ws + WS_SSP), gw, ngw, lane);
    }
    GRID_BAR();
    if (gridDim.y == 7777u) cg::this_grid().sync();

    for (int g = 0; g < 2; ++g) {
        const int S = g ? 2048 : 4096;
        { ArgsP a = largs(); unsigned char* ws = a->ws;
          pg8::StaticOrder<MG, 3072> so; so.init(G, bx); EpiConvIn E{WSB(WS_U), WSB(WS_GB), (const float*)(ws + WS_SSP + (size_t)(2 * g) * MiB)}; pg8::gemm_phase<D, D, D>(lds, g ? (const bf16_t*)(a->out + (size_t)MG * D) : WSB(WS_XB), WSB(WS_WIN), so, E); }
        GRID_BAR();
        {
            PH_IDS(); ArgsP a = largs(); unsigned char* ws = a->ws;
            const float* cw = a->in[4]; const float* cbv = a->in[5]; const bf16_t* Ub = WSB(WS_U); const bf16_t* GBb = WSB(WS_GB); bf16_t* A2 = WSB(WS_A2);
            const int ch0 = bx * 512 + tid, c = (ch0 & 127) * 8, tstep = (G * 512) >> 7;
            const f32x4 w0a = *(const f32x4*)(cw + c), w0b = *(const f32x4*)(cw + c + 4), w1a = *(const f32x4*)(cw + D + c), w1b = *(const f32x4*)(cw + D + c + 4), w2a = *(const f32x4*)(cw + 2 * D + c), w2b = *(const f32x4*)(cw + 2 * D + c + 4);
            const f32x4 ba = *(const f32x4*)(cbv + c), bb = *(const f32x4*)(cbv + c + 4);
            for (int t = ch0 >> 7; t < MG; t += tstep) {
                const int pos = t & (S - 1);
                const u32x4 z4 = {0u, 0u, 0u, 0u};
                const u32x4 um = (pos > 0) ? *(const u32x4*)(Ub + (size_t)(t - 1) * D + c) : z4;
                const u32x4 u0 = *(const u32x4*)(Ub + (size_t)t * D + c);
                const u32x4 up = (pos < S - 1) ? *(const u32x4*)(Ub + (size_t)(t + 1) * D + c) : z4;
                const u32x4 gb = __builtin_nontemporal_load((const u32x4*)(GBb + (size_t)t * D + c));
                f32x4 za, zb;
                za.x = ba.x + w0a.x * bf_lo(um.x) + w1a.x * bf_lo(u0.x) + w2a.x * bf_lo(up.x); za.y = ba.y + w0a.y * bf_hi(um.x) + w1a.y * bf_hi(u0.x) + w2a.y * bf_hi(up.x);
                za.z = ba.z + w0a.z * bf_lo(um.y) + w1a.z * bf_lo(u0.y) + w2a.z * bf_lo(up.y); za.w = ba.w + w0a.w * bf_hi(um.y) + w1a.w * bf_hi(u0.y) + w2a.w * bf_hi(up.y);
                zb.x = bb.x + w0b.x * bf_lo(um.z) + w1b.x * bf_lo(u0.z) + w2b.x * bf_lo(up.z); zb.y = bb.y + w0b.y * bf_hi(um.z) + w1b.y * bf_hi(u0.z) + w2b.y * bf_hi(up.z);
                zb.z = bb.z + w0b.z * bf_lo(um.w) + w1b.z * bf_lo(u0.w) + w2b.z * bf_lo(up.w); zb.w = bb.w + w0b.w * bf_hi(um.w) + w1b.w * bf_hi(u0.w) + w2b.w * bf_hi(up.w);
                za.x *= bf_lo(gb.x); za.y *= bf_hi(gb.x); za.z *= bf_lo(gb.y); za.w *= bf_hi(gb.y); zb.x *= bf_lo(gb.z); zb.y *= bf_hi(gb.z); zb.z *= bf_lo(gb.w); zb.w *= bf_hi(gb.w);
                *(u32x4*)(A2 + (size_t)t * D + c) = pack8(za, zb);
            }
        }
        GRID_BAR();
        { ArgsP a = largs(); unsigned char* ws = a->ws;
          pg8::StaticOrder<MG, D> so; so.init(G, bx);
          EpiRes E{a->in[g], WSB(WS_XB), (float*)(ws + WS_SSP + (size_t)(2 * g + 1) * MiB)}; pg8::gemm_phase<D, D, D>(lds, WSB(WS_A2), WSB(WS_WOUT), so, E); }
        GRID_BAR();
        { ArgsP a = largs(); unsigned char* ws = a->ws;
          pg8::StaticOrder<MG, FF> so; so.init(G, bx); EpiUp E{WSB(WS_HID), (const float*)(ws + WS_SSP + (size_t)(2 * g + 1) * MiB)}; pg8::gemm_phase<D, D, D>(lds, WSB(WS_XB), WSB(WS_WUP0), so, E); }
        GRID_BAR();
        { ArgsP a = largs(); unsigned char* ws = a->ws;
          pg8::StaticOrder<MG, D> so; so.init(G, bx); EpiRes E{nullptr, WSB(WS_XB), (float*)(ws + WS_SSP + (size_t)(2 * g) * MiB)}; pg8::gemm_phase<FF, FF, FF>(lds, WSB(WS_HID), WSB(WS_WDN0), so, E); }
        GRID_BAR();
        for (int sl = 0; sl < 2; ++sl) {
            { ArgsP a = largs(); unsigned char* ws = a->ws;
              const bf16_t* XBs = WSB(WS_XB) + (size_t)sl * SLAB * D; const float* sps = (const float*)(ws + WS_SSP + (size_t)(2 * g) * MiB) + (size_t)sl * SLAB * 16;
              QkvOrder so; so.init(G, bx);
              bf16_t* KFp = (bf16_t*)(a->out + (size_t)g * MG * D); bf16_t* KWp = KFp + (size_t)SLAB * 1024;
              EpiQKVG E{EpiQKG{WSB(WS_Q), WSB(WS_K), KFp, KWp, WSB(WS_A3) + (size_t)sl * SLAB * DVW, sps, (const float*)(ws + WS_ROPE), S - 1}, EpiVT{WSB(WS_VT), sps}};
              pg8::gemm_phase<D, D, D>(lds, XBs, WSB(WS_WQKG), so, E, WSB(WS_WV), XBs); }
            GRID_BAR();
            { ArgsP a = largs(); unsigned char* ws = a->ws;
              const bf16_t* KFp = (const bf16_t*)(a->out + (size_t)g * MG * D);
              chain_phase(lds, KFp, KFp + (size_t)SLAB * 1024, WSB(WS_VT), WSB(WS_ST), S, SLAB / S);
              if (g == 0 && bx >= 128) {
                  PH_IDS(); (void)gw; (void)ngw;
                  const size_t ro = (size_t)sl * SLAB;
                  xb_prep(a->in[1] + ro * D, (bf16_t*)(a->out + (size_t)MG * D) + ro * D, (float*)(ws + WS_SSP + 2 * MiB) + ro * 16, (bx - 128) * 8 + wave, (G - 128) * 8, lane, SLAB);
                  LAS float* scr = (LAS float*)(lds + wave * 16384);
                  const int iw = (bx - 128) * 8 + wave, niw = (G - 128) * 8;
                  if (sl == 0) { for (int it = iw; it < 32 * 32 + 128 * 16; it += niw) {
                          if (it < 32 * 32) { const int nb = it % 32, kb = it / 32; transpose_item<true>(a->in[12], 2048, 1024, nullptr, WSB(WS_WO), 32 * nb, 32 * nb, 64 * kb, scr, lane); }
                          else { const int r = it - 32 * 32, nb = r % 128, kb = r / 128; transpose_item<true>(a->in[14], 1024, 4096, a->in[13], WSB(WS_WUP1), 32 * nb, 32 * nb, 64 * kb, scr, lane); } } }
                  else { for (int it = iw; it < 32 * 64; it += niw) { const int nb = it % 32, kb = it / 32; transpose_item<true>(a->in[15], 4096, 1024, nullptr, WSB(WS_WDN1), 32 * nb, 32 * nb, 64 * kb, scr, lane); } } } }
            GRID_BAR();
            { ArgsP a = largs(); unsigned char* ws = a->ws;
              retention_phase(lds, WSB(WS_Q), WSB(WS_K), WSB(WS_VT), WSB(WS_ST), WSB(WS_A3) + (size_t)sl * SLAB * DVW, S); }
            GRID_BAR();
        }
        { ArgsP a = largs(); unsigned char* ws = a->ws;
          pg8::StaticOrder<MG, D> so; so.init(G, bx); EpiRes E{nullptr, WSB(WS_XB), (float*)(ws + WS_SSP + (size_t)(2 * g + 1) * MiB)}; pg8::gemm_phase<DVW, DVW, DVW>(lds, WSB(WS_A3), WSB(WS_WO), so, E); }
        GRID_BAR();
        { ArgsP a = largs(); unsigned char* ws = a->ws;
          pg8::StaticOrder<MG, FF> so; so.init(G, bx); EpiUp E{WSB(WS_HID), (const float*)(ws + WS_SSP + (size_t)(2 * g + 1) * MiB)}; pg8::gemm_phase<D, D, D>(lds, WSB(WS_XB), WSB(WS_WUP1), so, E); }
        GRID_BAR();
        { ArgsP a = largs(); unsigned char* ws = a->ws;
          pg8::StaticOrder<MG, D> so; so.init(G, bx);
          EpiFinal E{WSB(WS_XB), a->out + (size_t)g * MG * D, (float*)(ws + WS_SSP + (size_t)(2 * g) * MiB), a->in[16], (unsigned*)(ws + WS_CTL) + CW_FIN + g * 64 * 64};
          pg8::gemm_phase<FF, FF, FF>(lds, WSB(WS_HID), WSB(WS_WDN1), so, E); }
        if (g == 0) GRID_BAR();
    }
}

extern "C" void kernel_launch(void* const* d_in, const int* in_sizes, int n_in, void* d_out, int out_size, void* d_ws, size_t ws_size, hipStream_t stream) {
    static int grid = 0;
    if (grid == 0) {
        if (n_in != 17 || out_size != 2 * MG * D || ws_size < WS_END) { fprintf(stderr, "kernel_launch: unexpected shapes (n_in %d out %d ws %zu); nothing launched\n", n_in, out_size, ws_size); grid = -1; return; }
        int dev = 0, cus = 0, per_cu = 0;
        if (hipGetDevice(&dev) != hipSuccess || hipDeviceGetAttribute(&cus, hipDeviceAttributeMultiprocessorCount, dev) != hipSuccess) { grid = -1; return; }
        if (hipFuncSetAttribute((const void*)mega_fwd, hipFuncAttributeMaxDynamicSharedMemorySize, LDS_BYTES) != hipSuccess) { fprintf(stderr, "kernel_launch: hipFuncSetAttribute failed\n"); grid = -1; return; }
        if (hipOccupancyMaxActiveBlocksPerMultiprocessor(&per_cu, (const void*)mega_fwd, 512, LDS_BYTES) != hipSuccess || per_cu < 1) { fprintf(stderr, "kernel_launch: occupancy query says %d blocks/CU\n", per_cu); (void)hipGetLastError(); grid = -1; return; }
        grid = cus;
    }
    if (grid < 0) return;
    (void)hipMemsetAsync((char*)d_ws + WS_CTL, 0, CTL_ZERO_BYTES, stream);
    Args a{};
    for (int i = 0; i < 17; ++i) a.in[i] = (const float*)d_in[i];
    a.out = (float*)d_out; a.ws = (unsigned char*)d_ws;
    void* args[] = {&a};
    hipError_t e = hipLaunchCooperativeKernel((const void*)mega_fwd, dim3(grid), dim3(512), args, LDS_BYTES, stream);
    if (e != hipSuccess) fprintf(stderr, "cooperative launch failed: %s (grid %d)\n", hipGetErrorString(e), grid);
}
```

```cpp
#include <hip/hip_runtime.h>
#include <hip/hip_cooperative_groups.h>
#include <cstdio>
namespace cg = cooperative_groups;

#define LAS __attribute__((address_space(3)))
typedef unsigned short bf16_t;
typedef short bf16x8 __attribute__((ext_vector_type(8)));
typedef float f32x4 __attribute__((ext_vector_type(4)));
typedef float f32x2 __attribute__((ext_vector_type(2)));
typedef unsigned u32x4 __attribute__((ext_vector_type(4)));
typedef unsigned u32x2 __attribute__((ext_vector_type(2)));

constexpr int D = 1024, MG = 16384  , FF = 4096, SLAB = 8192, DVW = 2048;
constexpr float EPS = 1e-6f;
constexpr size_t MiB = 1u << 20;
constexpr size_t WS_CTL = 0, CTL_ZERO_BYTES = 65536;
constexpr size_t WS_SSP = 1 * MiB;
constexpr size_t WS_WIN = 8 * MiB, WS_WOUT = 14 * MiB, WS_WUP0 = 16 * MiB, WS_WDN0 = 24 * MiB, WS_WQKG = 32 * MiB, WS_WV = 40 * MiB, WS_WO = 44 * MiB, WS_WUP1 = 48 * MiB, WS_WDN1 = 56 * MiB;
constexpr size_t WS_XB = 64 * MiB;
constexpr size_t WS_BIG = 96 * MiB;
constexpr size_t WS_U = WS_BIG, WS_GB = WS_BIG + 32 * MiB, WS_A2 = WS_BIG + 64 * MiB;
constexpr size_t WS_HID = WS_BIG;
constexpr size_t WS_A3 = WS_BIG;
constexpr size_t WS_Q = WS_BIG + 64 * MiB, WS_K = WS_BIG + 80 * MiB, WS_VT = WS_BIG + 96 * MiB;
constexpr size_t WS_ROPE = 224 * MiB;
constexpr size_t WS_ST = 228 * MiB;
constexpr size_t WS_END = 256 * MiB;
constexpr int CW_FIN = 8192;
constexpr int CW_BAR = 4096;
constexpr int LDS_BYTES = 158720;
constexpr int MISC_OFF = 155648, RTAB_OFF = 156160;

__device__ __forceinline__ unsigned cvt_pk_bf16(float lo, float hi) { unsigned r; asm volatile("v_cvt_pk_bf16_f32 %0, %1, %2" : "=v"(r) : "v"(lo), "v"(hi)); return r; }
__device__ __forceinline__ float shx(float v, int mask, int lane) { return __builtin_bit_cast(float, __builtin_amdgcn_ds_bpermute((lane ^ mask) << 2, __builtin_bit_cast(int, v))); }
__device__ __forceinline__ unsigned f2bf_rne(float f) { const unsigned u = __float_as_uint(f); return (u + 0x7fffu + ((u >> 16) & 1u)) >> 16; }
__device__ __forceinline__ float bf_lo(unsigned w) { return __uint_as_float(w << 16); }
__device__ __forceinline__ float bf_hi(unsigned w) { return __uint_as_float(w & 0xffff0000u); }

#define XB_TMO      128
#define XB_XCNT(j)  (256  + 64 * (j))
#define XB_XSUB(j)  (1280 + 64 * (j))
#define XB_XGEN(j)  (2304 + 64 * (j))
#define XB_TOP      3328
#define XB_TOPGEN   3392
#define XCD_BAR_WORDS 3456
#define XB_SPIN_CAP (1u << 20)
__device__ __forceinline__ unsigned xb_ld(unsigned* p)              { return __hip_atomic_load(p, __ATOMIC_RELAXED, __HIP_MEMORY_SCOPE_AGENT); }
__device__ __forceinline__ unsigned xb_add(unsigned* p, unsigned v) { return __hip_atomic_fetch_add(p, v, __ATOMIC_RELAXED, __HIP_MEMORY_SCOPE_AGENT); }
__device__ __forceinline__ unsigned xb_xcc_id() { return (unsigned)__builtin_amdgcn_s_getreg((3 << 11) | 20) & 0xFu; }
#define XB_SPIN(cond, bar) do { unsigned _sp = 0; while (cond) { __builtin_amdgcn_s_sleep(1); \
    if ((++_sp & 255u) == 0u) { if (xb_ld(&(bar)[XB_TMO])) break; if (_sp > XB_SPIN_CAP) { atomicAdd(&(bar)[XB_TMO], 1u); break; } } } } while (0)
struct XcdBarrier { unsigned* bar; unsigned x; volatile LAS unsigned* st; };
__device__ __forceinline__ XcdBarrier xcd_barrier_post(unsigned* bar, volatile LAS unsigned* st) {
    XcdBarrier b; b.bar = bar; b.x = xb_xcc_id(); b.st = st;
    if (threadIdx.x == 0) (void)xb_add(&bar[XB_XCNT(b.x)], 1u);
    return b;
}
__device__ __forceinline__ void xcd_barrier_complete(unsigned* bar, unsigned x, unsigned& nloc, unsigned& nx) {
    const unsigned G = gridDim.x * gridDim.y * gridDim.z;
    unsigned sum, cnt, mine, sp = 0u;
    for (;;) {
        sum = 0u; cnt = 0u; mine = 0u;
#pragma unroll
        for (unsigned j = 0; j < 16; ++j) { const unsigned c = xb_ld(&bar[XB_XCNT(j)]); sum += c; cnt += (c > 0u) ? 1u : 0u; mine = (j == x) ? c : mine; }
        if (sum == G) break;
        __builtin_amdgcn_s_sleep(1);
        if ((++sp & 255u) == 0u) { if (xb_ld(&bar[XB_TMO])) break; if (sp > XB_SPIN_CAP) { atomicAdd(&bar[XB_TMO], 1u); break; } }
    }
    nloc = mine > 0u ? mine : 1u; nx = cnt > 0u ? cnt : 1u;
}
__device__ __forceinline__ void xcd_barrier(const XcdBarrier& b) {
    asm volatile("s_waitcnt vmcnt(0)" ::: "memory");
    __syncthreads();
    if (threadIdx.x == 0) {
        unsigned* bar = b.bar;
        __builtin_amdgcn_s_waitcnt(0);
        unsigned nloc = b.st[0], nx = b.st[1];
        if (nloc == 0u) { xcd_barrier_complete(bar, b.x, nloc, nx); b.st[0] = nloc; b.st[1] = nx; }
        const unsigned old = xb_add(&bar[XB_XSUB(b.x)], 1u);
        const unsigned gen = old / nloc;
        if (old + 1u == (gen + 1u) * nloc) {
            __builtin_amdgcn_fence(__ATOMIC_RELEASE, "agent");
            asm volatile("s_waitcnt vmcnt(0)" ::: "memory");
            const unsigned og = xb_add(&bar[XB_TOP], 1u);
            const unsigned tg = og / nx;
            if (og + 1u == (tg + 1u) * nx) xb_add(&bar[XB_TOPGEN], 1u);
            else XB_SPIN(xb_ld(&bar[XB_TOPGEN]) == tg, bar);
            __builtin_amdgcn_fence(__ATOMIC_ACQUIRE, "agent");
            xb_add(&bar[XB_XGEN(b.x)], 1u);
            asm volatile("s_waitcnt vmcnt(0)" ::: "memory");
        } else {
            XB_SPIN(xb_ld(&bar[XB_XGEN(b.x)]) == gen, bar);
            __builtin_amdgcn_fence(__ATOMIC_ACQUIRE, "agent");
            asm volatile("s_waitcnt vmcnt(0)" ::: "memory");
        }
    }
    __syncthreads();
}

namespace pg8 {
constexpr int BM = 256, BK = 64, HALF = 128, HTB = HALF * BK * 2, STAGE_BYTES = 8 * HTB, NXCD = 8, WGM = 8;
__host__ __device__ __forceinline__ int lds_byte(int r, int c) { const int st = (r >> 4) * 2 + (c >> 5), rr = r & 15, cc = c & 31, ob = rr * 64 + cc * 2; return st * 1024 + (ob ^ (((ob >> 9) & 1) << 5)); }
__host__ __device__ __forceinline__ void stage_rc(int b, int& R, int& C) { const int st = b / 1024, sb = b % 1024, swz = sb ^ (((sb >> 9) & 1) << 5); R = (st >> 1) * 16 + swz / 64; C = (st & 1) * 32 + (swz % 64) / 2; }
__host__ __device__ __forceinline__ int perm32(int rho) { const int n = rho >> 4, i = rho & 15; return 8 * (i >> 2) + 4 * n + (i & 3); }
struct Unit { int pm, pn, ty; };
template <int M_, int N_> struct StaticOrder {
    static constexpr int nM = M_ / BM, nN = N_ / BM, nwg = nM * nN;
    int G, c;
    __device__ __forceinline__ void init(int G_, int c_) { G = G_; c = c_; }
    __device__ __forceinline__ bool next(int i, Unit& u) const {
        const int L = i * G + c; if (L >= nwg) return false;
        int wgid = L; { constexpr int q = nwg / NXCD, r = nwg % NXCD; const int xcd = wgid % NXCD, off = wgid / NXCD; wgid = (xcd < r ? xcd * (q + 1) : r * (q + 1) + (xcd - r) * q) + off; }
        constexpr int nig = WGM * nN; const int gid = wgid / nig, fm = gid * WGM, gsz = (nM - fm) < WGM ? (nM - fm) : WGM;
        u.pm = fm + ((wgid % nig) % gsz); u.pn = (wgid % nig) / gsz; u.ty = 0; return true;
    }
};

template <int LDA, int LDB, int KK, class Epi, class Sched>
__device__ __forceinline__ void gemm_phase(LAS unsigned char* lds, const bf16_t* gA, const bf16_t* gB, const Sched& S, const Epi& E, const bf16_t* gA2 = nullptr, const bf16_t* gB2 = nullptr) {
    int tid_ = threadIdx.x; asm volatile("" : "+v"(tid_));
    const int tid = tid_, wid = __builtin_amdgcn_readfirstlane(tid >> 6), lane = tid & 63, wr = wid >> 2, wc = wid & 3, fr = lane & 15, fq = lane >> 4;
    constexpr int nt = KK / BK;
    unsigned voffA[2], voffB[2];
#pragma unroll
    for (int i = 0; i < 2; ++i) { int R, C; stage_rc(tid * 16 + i * 8192, R, C); const int Rb = Epi::PERM ? ((R & ~31) + perm32(R & 31)) : R;
        voffA[i] = (unsigned)(R * LDA + C) * 2u; voffB[i] = (unsigned)(Rb * LDB + C) * 2u; }
    constexpr size_t kstep = (size_t)(BK * 2);
    constexpr size_t hstepA = (size_t)HALF * LDA * 2, hstepB = (size_t)HALF * LDB * 2;
    constexpr size_t tstepA = 2 * hstepA, tstepB = 2 * hstepB;
    const unsigned ldsw = (unsigned)wid * 1024u;
    const int aoff = lds_byte(wr * 64 + fr, fq * 8), boff = lds_byte(wc * 32 + fr, fq * 8);
#define PG8_SA(b, h) (((b) * 2 + (h)) * HTB)
#define PG8_SB(b, h) ((4 + (b) * 2 + (h)) * HTB)
#define PG8_STAGE(bufoff, gbase, voff) do { _Pragma("unroll") for (int _i = 0; _i < 2; ++_i) \
        __builtin_amdgcn_global_load_lds((const unsigned*)((const char*)(gbase) + (voff)[_i]), (LAS unsigned*)(lds + (bufoff) + ldsw + _i * 8192), 16, 0, 0); } while (0)
#define PG8_LDA(dst, b, h) do { _Pragma("unroll") for (int m = 0; m < 4; ++m) _Pragma("unroll") for (int k = 0; k < 2; ++k) dst[m][k] = *(const LAS bf16x8*)(lds + PG8_SA(b, h) + aoff + m * 2048 + k * 1024); } while (0)
#define PG8_LDB(dst, b, h) do { _Pragma("unroll") for (int n = 0; n < 2; ++n) _Pragma("unroll") for (int k = 0; k < 2; ++k) dst[n][k] = *(const LAS bf16x8*)(lds + PG8_SB(b, h) + boff + n * 2048 + k * 1024); } while (0)
#define PG8_MMA(ai, bj, At, Bt) do { __builtin_amdgcn_s_setprio(1); _Pragma("unroll") for (int m = 0; m < 4; ++m) _Pragma("unroll") for (int n = 0; n < 2; ++n) _Pragma("unroll") for (int k = 0; k < 2; ++k) \
        acc[ai][bj][m][n] = __builtin_amdgcn_mfma_f32_16x16x32_bf16(Bt[n][k], At[m][k], acc[ai][bj][m][n], 0, 0, 0); __builtin_amdgcn_s_setprio(0); } while (0)
#define PG8_WAIT_V(n) asm volatile("s_waitcnt vmcnt(" #n ")" ::: "memory")
#define PG8_WAIT_L(n) asm volatile("s_waitcnt lgkmcnt(" #n ")" ::: "memory")
#define PG8_BAR __builtin_amdgcn_s_barrier()
#define PG8_SCHED __builtin_amdgcn_sched_barrier(0)
    Unit cur, nxt; int ui = 0;
    if (!S.next(0, cur)) return;
    LAS float* rtab = (LAS float*)(lds + RTAB_OFF);
    { const typename Epi::Pre p0 = E.prep_load(cur, tid); E.prep_store(p0, rtab, tid); }
    f32x4 acc[2][2][4][2];
#pragma unroll
    for (int a = 0; a < 2; ++a)
#pragma unroll
        for (int b = 0; b < 2; ++b)
#pragma unroll
            for (int m = 0; m < 4; ++m)
#pragma unroll
                for (int n = 0; n < 2; ++n) acc[a][b][m][n] = (f32x4){0.f, 0.f, 0.f, 0.f};
    bf16x8 At[4][2], B0[2][2], B1[2][2];
    const char* cA = (const char*)(cur.ty ? gA2 : gA) + (size_t)cur.pm * tstepA; const char* cB = (const char*)(cur.ty ? gB2 : gB) + (size_t)cur.pn * tstepB;
    PG8_STAGE(PG8_SB(0, 0), cB, voffB); PG8_STAGE(PG8_SB(0, 1), cB + hstepB, voffB); PG8_STAGE(PG8_SA(0, 0), cA, voffA); PG8_STAGE(PG8_SA(0, 1), cA + hstepA, voffA);
    if (wr == 1) PG8_BAR;
    PG8_WAIT_V(2); PG8_BAR;
    PG8_STAGE(PG8_SB(1, 0), cB + kstep, voffB); PG8_STAGE(PG8_SA(1, 0), cA + kstep, voffA); PG8_STAGE(PG8_SB(1, 1), cB + hstepB + kstep, voffB);
    PG8_WAIT_V(6); PG8_BAR;
    for (;;) {
        const bool has_next = S.next(ui + 1, nxt);
        const char* nA = has_next ? (const char*)(nxt.ty ? gA2 : gA) + (size_t)nxt.pm * tstepA : cA; const char* nB = has_next ? (const char*)(nxt.ty ? gB2 : gB) + (size_t)nxt.pn * tstepB : cB;
        for (int t = 0; t < nt; t += 2) {
            const bool last = (t == nt - 2);
            const char* a1 = cA + (size_t)(t + 1) * kstep;
            const char* a2 = last ? nA : cA + (size_t)(t + 2) * kstep; const char* b2 = last ? nB : cB + (size_t)(t + 2) * kstep;
            const char* a3 = a2 + kstep; const char* b3 = b2 + kstep;
            PG8_LDB(B0, 0, 0); PG8_LDB(B1, 0, 1); PG8_SCHED; PG8_LDA(At, 0, 0); PG8_STAGE(PG8_SA(1, 1), a1 + hstepA, voffA);
            PG8_WAIT_V(8); PG8_WAIT_L(0); PG8_BAR; PG8_MMA(0, 0, At, B0); PG8_MMA(0, 1, At, B1); PG8_BAR; PG8_SCHED;
            PG8_LDA(At, 0, 1); PG8_STAGE(PG8_SB(0, 0), b2, voffB); PG8_STAGE(PG8_SB(0, 1), b2 + hstepB, voffB); PG8_STAGE(PG8_SA(0, 0), a2, voffA);
            PG8_WAIT_V(8); PG8_WAIT_L(0); PG8_BAR; PG8_MMA(1, 0, At, B0); PG8_MMA(1, 1, At, B1); PG8_BAR; PG8_SCHED;
            PG8_LDB(B0, 1, 0); PG8_LDB(B1, 1, 1); PG8_SCHED; PG8_LDA(At, 1, 0); PG8_STAGE(PG8_SA(0, 1), a2 + hstepA, voffA);
            PG8_WAIT_V(8); PG8_WAIT_L(0); PG8_BAR; PG8_MMA(0, 0, At, B0); PG8_MMA(0, 1, At, B1); PG8_BAR; PG8_SCHED;
            PG8_LDA(At, 1, 1); PG8_STAGE(PG8_SB(1, 0), b3, voffB); PG8_STAGE(PG8_SB(1, 1), b3 + hstepB, voffB); PG8_STAGE(PG8_SA(1, 0), a3, voffA);
            PG8_WAIT_V(8); PG8_WAIT_L(0); PG8_BAR; PG8_MMA(1, 0, At, B0); PG8_MMA(1, 1, At, B1); PG8_BAR; PG8_SCHED;
        }
        if (wr == 0) PG8_BAR;
        typename Epi::Pre pre; if (has_next) pre = E.prep_load(nxt, tid);
        if constexpr (Epi::FINAL) E.final(acc, cur, wr, wc, fr, fq, rtab, tid, wid, lane); else E(acc, cur, wr, wc, fr, fq, rtab + (ui & 1) * 256);
        if (!has_next) break;
#pragma unroll
        for (int a = 0; a < 2; ++a)
#pragma unroll
            for (int b = 0; b < 2; ++b)
#pragma unroll
                for (int m = 0; m < 4; ++m)
#pragma unroll
                    for (int n = 0; n < 2; ++n) acc[a][b][m][n] = (f32x4){0.f, 0.f, 0.f, 0.f};
        cur = nxt; cA = nA; cB = nB; ++ui;
        E.prep_store(pre, rtab + (ui & 1) * 256, tid);
        if (wr == 1) PG8_BAR;
    }
    PG8_WAIT_V(0);
    PG8_BAR;
#undef PG8_SA
#undef PG8_SB
#undef PG8_STAGE
#undef PG8_LDA
#undef PG8_LDB
#undef PG8_MMA
#undef PG8_WAIT_V
#undef PG8_WAIT_L
#undef PG8_BAR
#undef PG8_SCHED
}
}

__device__ __forceinline__ float lg_f(int h) { return __builtin_amdgcn_logf(1.0f - __builtin_amdgcn_exp2f(-5.0f - (float)h)); }
__device__ __forceinline__ float lg_b(int h) { return __builtin_amdgcn_logf(1.0f - __builtin_amdgcn_exp2f(-5.5f - (float)h)); }
typedef f32x4 AccT[2][2][4][2];
__device__ __forceinline__ float row_scale(const float* ssp, int r) {
    const f32x4* p = (const f32x4*)(ssp + (size_t)r * 16); const f32x4 a = p[0], b = p[1], c = p[2], d = p[3];
    const float s = ((a.x + a.y) + (a.z + a.w)) + ((b.x + b.y) + (b.z + b.w)) + ((c.x + c.y) + (c.z + c.w)) + ((d.x + d.y) + (d.z + d.w));
    return __builtin_amdgcn_rsqf(s * (1.0f / 1024.0f) + EPS);
}
struct PreNone {};
struct PreSS { f32x4 a, b, c, d; };
__device__ __forceinline__ PreSS ss_load(const float* ssp, int r0, int tid) { PreSS p; if (tid < 256) { const f32x4* q = (const f32x4*)(ssp + (size_t)(r0 + tid) * 16); p.a = q[0]; p.b = q[1]; p.c = q[2]; p.d = q[3]; } else { p.a = p.b = p.c = p.d = (f32x4){0.f, 0.f, 0.f, 0.f}; } return p; }
__device__ __forceinline__ void ss_store(const PreSS& p, LAS float* tab, int tid) {
    const float s = ((p.a.x + p.a.y) + (p.a.z + p.a.w)) + ((p.b.x + p.b.y) + (p.b.z + p.b.w)) + ((p.c.x + p.c.y) + (p.c.z + p.c.w)) + ((p.d.x + p.d.y) + (p.d.z + p.d.w));
    if (tid < 256) tab[tid] = __builtin_amdgcn_rsqf(s * (1.0f / 1024.0f) + EPS); }
__device__ __forceinline__ u32x4 pack8(const f32x4 a, const f32x4 b) { u32x4 w; w.x = cvt_pk_bf16(a.x, a.y); w.y = cvt_pk_bf16(a.z, a.w); w.z = cvt_pk_bf16(b.x, b.y); w.w = cvt_pk_bf16(b.z, b.w); return w; }
#define EPI_FENCE() asm volatile("" ::: "memory")
__device__ __forceinline__ void store_wt(void* p, u32x4 v) { asm volatile("global_store_dwordx4 %0, %1, off sc1\n\ts_nop 1" :: "v"(p), "v"(v) : "memory"); }

struct EpiConvIn { static constexpr bool FINAL = false, PERM = true; bf16_t* U; bf16_t* GB; const float* ssp;
    typedef PreSS Pre;
    __device__ __forceinline__ Pre prep_load(const pg8::Unit& u, int tid) const { return ss_load(ssp, u.pm * 256, tid); }
    __device__ __forceinline__ void prep_store(const Pre& p, LAS float* tab, int tid) const { ss_store(p, tab, tid); }
    __device__ __forceinline__ void operator()(const AccT& acc, const pg8::Unit& u, int wr, int wc, int fr, int fq, const LAS float* tab) const {
        const int rl0 = wr * 64 + fr;
#pragma unroll
        for (int ai = 0; ai < 2; ++ai)
#pragma unroll
            for (int m = 0; m < 4; ++m) { const int rl = rl0 + ai * 128 + m * 16, r = u.pm * 256 + rl; const float rs = tab[rl];
                if (u.pn < 8) { const float r2 = rs * rs;
                    const f32x4 u0 = acc[ai][0][m][0] * acc[ai][1][m][0] * r2, u1 = acc[ai][0][m][1] * acc[ai][1][m][1] * r2;
                    *(u32x4*)(U + (size_t)r * D + 128 * u.pn + 32 * wc + 8 * fq) = pack8(u0, u1);
                } else {
#pragma unroll
                    for (int bj = 0; bj < 2; ++bj) *(u32x4*)(GB + (size_t)r * D + 256 * (u.pn - 8) + 128 * bj + 32 * wc + 8 * fq) = pack8(acc[ai][bj][m][0] * rs, acc[ai][bj][m][1] * rs);
                } }
    }
};
struct EpiRes { static constexpr bool FINAL = false, PERM = false; const float* Xin; bf16_t* XB; float* ssp;
    typedef PreNone Pre;
    __device__ __forceinline__ Pre prep_load(const pg8::Unit&, int) const { return Pre{}; }
    __device__ __forceinline__ void prep_store(const Pre&, LAS float*, int) const {}
    __device__ __forceinline__ void operator()(const AccT& acc, const pg8::Unit& u, int wr, int wc, int fr, int fq, const LAS float*) const {
        const int row0 = u.pm * 256 + wr * 64 + fr, col0 = u.pn * 256 + wc * 32 + 4 * fq;
#pragma unroll
        for (int ai = 0; ai < 2; ++ai)
            {
                f32x4 xr[4][2][2];
#pragma unroll
                for (int mm = 0; mm < 4; ++mm)
#pragma unroll
                    for (int bj = 0; bj < 2; ++bj)
#pragma unroll
                        for (int n = 0; n < 2; ++n) { const size_t o = (size_t)(row0 + ai * 128 + mm * 16) * D + col0 + bj * 128 + n * 16;
                            if (Xin) xr[mm][bj][n] = __builtin_nontemporal_load((const f32x4*)(Xin + o));
                            else { const u32x2 w = *(const u32x2*)(XB + o); xr[mm][bj][n] = (f32x4){bf_lo(w.x), bf_hi(w.x), bf_lo(w.y), bf_hi(w.y)}; } }
                EPI_FENCE();
#pragma unroll
                for (int mm = 0; mm < 4; ++mm) { const int m = mm, r = row0 + ai * 128 + m * 16; float ss = 0.f;
#pragma unroll
                    for (int bj = 0; bj < 2; ++bj)
#pragma unroll
                        for (int n = 0; n < 2; ++n) { const size_t o = (size_t)r * D + col0 + bj * 128 + n * 16;
                            const f32x4 x = xr[mm][bj][n] + acc[ai][bj][m][n];
                            ss += (x.x * x.x + x.y * x.y) + (x.z * x.z + x.w * x.w);
                            u32x2 w; w.x = cvt_pk_bf16(x.x, x.y); w.y = cvt_pk_bf16(x.z, x.w); *(u32x2*)(XB + o) = w; }
                    { const int ln = fr + 16 * fq; ss += shx(ss, 16, ln); ss += shx(ss, 32, ln); }
                    if (fq == 0) ssp[(size_t)r * 16 + 4 * u.pn + wc] = ss; }
                EPI_FENCE(); }
    }
};
struct EpiFinal { static constexpr bool FINAL = true, PERM = false; const bf16_t* XB; float* out; float* ssp; const float* gfin; unsigned* cnt;
    typedef PreNone Pre;
    __device__ __forceinline__ Pre prep_load(const pg8::Unit&, int) const { return Pre{}; }
    __device__ __forceinline__ void prep_store(const Pre&, LAS float*, int) const {}
    __device__ __forceinline__ void final(AccT& acc, const pg8::Unit& u, int wr, int wc, int fr, int fq, LAS float* tab, int tid, int wid, int lane) const {
        const int row0 = u.pm * 256 + wr * 64 + fr, col0 = u.pn * 256 + wc * 32 + 4 * fq;
#pragma unroll
        for (int ai = 0; ai < 2; ++ai)
            {
                f32x4 xr[4][2][2];
#pragma unroll
                for (int mm = 0; mm < 4; ++mm)
#pragma unroll
                    for (int bj = 0; bj < 2; ++bj)
#pragma unroll
                        for (int n = 0; n < 2; ++n) { const u32x2 w = *(const u32x2*)(XB + (size_t)(row0 + ai * 128 + mm * 16) * D + col0 + bj * 128 + n * 16); xr[mm][bj][n] = (f32x4){bf_lo(w.x), bf_hi(w.x), bf_lo(w.y), bf_hi(w.y)}; }
                EPI_FENCE();
#pragma unroll
                for (int mm = 0; mm < 4; ++mm) { const int m = mm, r = row0 + ai * 128 + m * 16; float ss = 0.f;
#pragma unroll
                    for (int bj = 0; bj < 2; ++bj)
#pragma unroll
                        for (int n = 0; n < 2; ++n) { const f32x4 x = xr[mm][bj][n] + acc[ai][bj][m][n]; acc[ai][bj][m][n] = x; ss += (x.x * x.x + x.y * x.y) + (x.z * x.z + x.w * x.w); }
                    { const int ln = fr + 16 * fq; ss += shx(ss, 16, ln); ss += shx(ss, 32, ln); }
                    if (fq == 0) ssp[(size_t)r * 16 + 4 * u.pn + wc] = ss; }
                EPI_FENCE(); }
        asm volatile("s_waitcnt vmcnt(0)" ::: "memory");
        __builtin_amdgcn_s_barrier();
        asm volatile("" ::: "memory");
        if (wid == 0) {
            unsigned* c = cnt + 64 * u.pm;
            __builtin_amdgcn_fence(__ATOMIC_RELEASE, "agent");
            asm volatile("s_waitcnt vmcnt(0)" ::: "memory");
            if (lane == 0) (void)__hip_atomic_fetch_add(c, 1u, __ATOMIC_RELAXED, __HIP_MEMORY_SCOPE_AGENT);
            unsigned sp = 0;
            while ((unsigned)__builtin_amdgcn_readfirstlane(__hip_atomic_load(c, __ATOMIC_RELAXED, __HIP_MEMORY_SCOPE_AGENT)) < 4u) { __builtin_amdgcn_s_sleep(2); if (++sp > (1u << 22)) break; }
            __builtin_amdgcn_fence(__ATOMIC_ACQUIRE, "agent");
            asm volatile("s_waitcnt vmcnt(0)" ::: "memory");
        }
        __builtin_amdgcn_s_barrier();
        asm volatile("" ::: "memory");
        if (tid < 256) tab[tid] = row_scale(ssp, u.pm * 256 + tid);
        f32x4 gv[2][2];
#pragma unroll
        for (int bj = 0; bj < 2; ++bj)
#pragma unroll
            for (int n = 0; n < 2; ++n) gv[bj][n] = *(const f32x4*)(gfin + col0 + bj * 128 + n * 16);
        asm volatile("s_waitcnt lgkmcnt(0)" ::: "memory");
        __builtin_amdgcn_s_barrier();
        asm volatile("" ::: "memory");
#pragma unroll
        for (int ai = 0; ai < 2; ++ai)
#pragma unroll
            for (int m = 0; m < 4; ++m) { const int rl = wr * 64 + fr + ai * 128 + m * 16; const float rs = tab[rl];
#pragma unroll
                for (int bj = 0; bj < 2; ++bj)
#pragma unroll
                    for (int n = 0; n < 2; ++n) __builtin_nontemporal_store(acc[ai][bj][m][n] * rs * gv[bj][n], (f32x4*)(out + (size_t)(u.pm * 256 + rl) * D + col0 + bj * 128 + n * 16)); }
    }
};
struct EpiUp { static constexpr bool FINAL = false, PERM = true; bf16_t* H; const float* ssp;
    typedef PreSS Pre;
    __device__ __forceinline__ Pre prep_load(const pg8::Unit& u, int tid) const { return ss_load(ssp, u.pm * 256, tid); }
    __device__ __forceinline__ void prep_store(const Pre& p, LAS float* tab, int tid) const { ss_store(p, tab, tid); }
    __device__ __forceinline__ void operator()(const AccT& acc, const pg8::Unit& u, int wr, int wc, int fr, int fq, const LAS float* tab) const {
        const int rl0 = wr * 64 + fr;
#pragma unroll
        for (int ai = 0; ai < 2; ++ai)
#pragma unroll
            for (int m = 0; m < 4; ++m) { const int rl = rl0 + ai * 128 + m * 16, r = u.pm * 256 + rl; const float rs = tab[rl];
#pragma unroll
                for (int bj = 0; bj < 2; ++bj) { f32x4 a = acc[ai][bj][m][0] * rs, b = acc[ai][bj][m][1] * rs;
                    a = __builtin_elementwise_max(a, (f32x4){0.f, 0.f, 0.f, 0.f}); b = __builtin_elementwise_max(b, (f32x4){0.f, 0.f, 0.f, 0.f});
                    store_wt(H + (size_t)r * FF + 256 * u.pn + 128 * bj + 32 * wc + 8 * fq, pack8(a * a, b * b)); } }
    }
};
struct EpiQKG { static constexpr bool FINAL = false, PERM = true; bf16_t* Q; bf16_t* Kb; bf16_t* KF; bf16_t* KW; bf16_t* A3; const float* ssp; const float* rope; int smask;
    typedef PreSS Pre;
    __device__ __forceinline__ Pre prep_load(const pg8::Unit& u, int tid) const { return ss_load(ssp, u.pm * 256, tid); }
    __device__ __forceinline__ void prep_store(const Pre& p, LAS float* tab, int tid) const { ss_store(p, tab, tid); }
    __device__ __forceinline__ void operator()(const AccT& acc, const pg8::Unit& u, int wr, int wc, int fr, int fq, const LAS float* tab) const {
        const int rl0 = wr * 64 + fr;
#pragma unroll
        for (int ai = 0; ai < 2; ++ai)
#pragma unroll
            for (int m = 0; m < 4; ++m) { const int rl = rl0 + ai * 128 + m * 16, r = u.pm * 256 + rl; const float rs = tab[rl];
                if (u.pn < 8) {
                    const int c = 32 * wc + 8 * fq; const float sc = (u.pn < 4) ? rs * 0.0625f : rs;
                    const f32x4* tp = (const f32x4*)(rope + ((size_t)(r & smask) * 128 + c) * 2);
                    const f32x4 t0 = tp[0], t1 = tp[1], t2 = tp[2], t3 = tp[3];
                    const f32x4 x1a = acc[ai][0][m][0] * sc, x1b = acc[ai][0][m][1] * sc, x2a = acc[ai][1][m][0] * sc, x2b = acc[ai][1][m][1] * sc;
                    const f32x4 ca = {t0.x, t0.z, t1.x, t1.z}, sa = {t0.y, t0.w, t1.y, t1.w}, cb = {t2.x, t2.z, t3.x, t3.z}, sb = {t2.y, t2.w, t3.y, t3.w};
                    const f32x4 o1a = x1a * ca - x2a * sa, o1b = x1b * cb - x2b * sb, o2a = x1a * sa + x2a * ca, o2b = x1b * sb + x2b * cb;
                    bf16_t* dst = ((u.pn < 4) ? Q : Kb) + (size_t)r * 1024 + 256 * (u.pn & 3) + c;
                    *(u32x4*)(dst) = pack8(o1a, o1b); *(u32x4*)(dst + 128) = pack8(o2a, o2b);
                    if (u.pn >= 4) { const int hh = u.pn & 3, tt = r & 511; const size_t ko = (size_t)r * 1024 + 256 * hh + c;
                        const float wf = __builtin_amdgcn_exp2f(lg_f(hh) * (float)(511 - tt)), wb = __builtin_amdgcn_exp2f(lg_b(hh) * (float)tt);
                        *(u32x4*)(KF + ko) = pack8(o1a * wf, o1b * wf); *(u32x4*)(KF + ko + 128) = pack8(o2a * wf, o2b * wf);
                        *(u32x4*)(KW + ko) = pack8(o1a * wb, o1b * wb); *(u32x4*)(KW + ko + 128) = pack8(o2a * wb, o2b * wb); }
                    if (m == 3) EPI_FENCE();
                } else {
#pragma unroll
                    for (int bj = 0; bj < 2; ++bj) { f32x4 a = acc[ai][bj][m][0] * rs, b = acc[ai][bj][m][1] * rs;
#pragma unroll
                        for (int i = 0; i < 4; ++i) { a[i] = a[i] * __builtin_amdgcn_rcpf(1.0f + __builtin_amdgcn_exp2f(-1.44269504f * a[i])); b[i] = b[i] * __builtin_amdgcn_rcpf(1.0f + __builtin_amdgcn_exp2f(-1.44269504f * b[i])); }
                        *(u32x4*)(A3 + (size_t)r * DVW + 256 * (u.pn - 8) + 128 * bj + 32 * wc + 8 * fq) = pack8(a, b); }
                } }
    }
};
struct EpiVT { static constexpr bool FINAL = false, PERM = true; bf16_t* VT; const float* ssp;
    typedef PreSS Pre;
    __device__ __forceinline__ Pre prep_load(const pg8::Unit& u, int tid) const { return ss_load(ssp, u.pn * 256, tid); }
    __device__ __forceinline__ void prep_store(const Pre& p, LAS float* tab, int tid) const { ss_store(p, tab, tid); }
    __device__ __forceinline__ void operator()(const AccT& acc, const pg8::Unit& u, int wr, int wc, int fr, int fq, const LAS float* tab) const {
        const int row0 = u.pm * 256 + wr * 64 + fr, cl0 = 32 * wc + 8 * fq, col0 = u.pn * 256 + cl0;
        f32x4 s[2][2];
#pragma unroll
        for (int bj = 0; bj < 2; ++bj)
#pragma unroll
            for (int n = 0; n < 2; ++n) s[bj][n] = *(const LAS f32x4*)(tab + cl0 + 128 * bj + 4 * n);
#pragma unroll
        for (int ai = 0; ai < 2; ++ai)
#pragma unroll
            for (int m = 0; m < 4; ++m) { const int r = row0 + ai * 128 + m * 16;
#pragma unroll
                for (int bj = 0; bj < 2; ++bj) *(u32x4*)(VT + (size_t)r * SLAB + col0 + 128 * bj) = pack8(acc[ai][bj][m][0] * s[bj][0], acc[ai][bj][m][1] * s[bj][1]); }
    }
};

struct QkvOrder { pg8::StaticOrder<SLAB, 4096> s0; pg8::StaticOrder<DVW, SLAB> s1;
    __device__ __forceinline__ void init(int G_, int c_) { s0.init(G_, c_); s1.init(G_, c_); }
    __device__ __forceinline__ bool next(int i, pg8::Unit& u) const { if (i < 2) return s0.next(i, u); const bool ok = s1.next(i - 2, u); u.ty = 1; return ok; }
};
struct EpiQKVG { static constexpr bool FINAL = false, PERM = true; EpiQKG a; EpiVT b;
    typedef PreSS Pre;
    __device__ __forceinline__ Pre prep_load(const pg8::Unit& u, int tid) const { return u.ty ? b.prep_load(u, tid) : a.prep_load(u, tid); }
    __device__ __forceinline__ void prep_store(const Pre& p, LAS float* tab, int tid) const { ss_store(p, tab, tid); }
    __device__ __forceinline__ void operator()(const AccT& acc, const pg8::Unit& u, int wr, int wc, int fr, int fq, const LAS float* tab) const { if (u.ty) b(acc, u, wr, wc, fr, fq, tab); else a(acc, u, wr, wc, fr, fq, tab); }
};

__device__ __forceinline__ float wave_sum(float v, int lane) {
#pragma unroll
    for (int o = 1; o < 64; o <<= 1) v += shx(v, o, lane);
    return v;
}
template <bool NTS = false>
__device__ __forceinline__ void transpose_item(const float* W, int K, int N, const float* gain, bf16_t* WT, int drow0, int scol0, int k0, LAS float* scr, int lane) {
    f32x4 v[8];
#pragma unroll
    for (int i = 0; i < 8; ++i) { const int kk = 8 * i + (lane >> 3); v[i] = __builtin_nontemporal_load((const f32x4*)(W + (size_t)(k0 + kk) * N + scol0 + 4 * (lane & 7))); }
#pragma unroll
    for (int i = 0; i < 8; ++i) { const int kk = 8 * i + (lane >> 3); const float gv = gain ? gain[k0 + kk] : 1.0f; LAS float* d = scr + kk * 33 + 4 * (lane & 7);
        d[0] = v[i].x * gv; d[1] = v[i].y * gv; d[2] = v[i].z * gv; d[3] = v[i].w * gv; }
    asm volatile("s_waitcnt lgkmcnt(0)" ::: "memory");
    const int c = lane & 7;
#pragma unroll
    for (int j = 0; j < 4; ++j) { const int n = (lane >> 3) + 8 * j; const LAS float* s = scr + (8 * c) * 33 + n;
        u32x4 o; o.x = cvt_pk_bf16(s[0 * 33], s[1 * 33]); o.y = cvt_pk_bf16(s[2 * 33], s[3 * 33]); o.z = cvt_pk_bf16(s[4 * 33], s[5 * 33]); o.w = cvt_pk_bf16(s[6 * 33], s[7 * 33]);
        if (NTS) __builtin_nontemporal_store(o, (u32x4*)(WT + (size_t)(drow0 + n) * K + k0 + 8 * c)); else *(u32x4*)(WT + (size_t)(drow0 + n) * K + k0 + 8 * c) = o; }
    asm volatile("s_waitcnt lgkmcnt(0)" ::: "memory");
}
template <bool NTS = false>
__device__ __forceinline__ void xb_prep(const float* x, bf16_t* XB, float* ssp, int gw, int ngw, int lane, int nrows = MG) {
    for (int r = gw; r < nrows; r += 2 * ngw) {
        const int r2 = r + ngw;
        const f32x4* xa = (const f32x4*)(x + (size_t)r * D) + lane; const f32x4* xb = (const f32x4*)(x + (size_t)r2 * D) + lane;
        f32x4 va[4], vb[4];
#pragma unroll
        for (int j = 0; j < 4; ++j) { va[j] = __builtin_nontemporal_load(xa + 64 * j); vb[j] = __builtin_nontemporal_load(xb + 64 * j); }
        unsigned long long* oa = (unsigned long long*)(XB + (size_t)r * D) + lane; unsigned long long* ob = (unsigned long long*)(XB + (size_t)r2 * D) + lane;
        float sa = 0.f, sb2 = 0.f;
#pragma unroll
        for (int j = 0; j < 4; ++j) { const f32x4 v = va[j], w = vb[j];
            sa += (v.x * v.x + v.y * v.y) + (v.z * v.z + v.w * v.w); sb2 += (w.x * w.x + w.y * w.y) + (w.z * w.z + w.w * w.w);
            const unsigned long long pa = (unsigned long long)cvt_pk_bf16(v.x, v.y) | ((unsigned long long)cvt_pk_bf16(v.z, v.w) << 32), pb = (unsigned long long)cvt_pk_bf16(w.x, w.y) | ((unsigned long long)cvt_pk_bf16(w.z, w.w) << 32);
            if (NTS) { __builtin_nontemporal_store(pa, oa + 64 * j); __builtin_nontemporal_store(pb, ob + 64 * j); } else { oa[64 * j] = pa; ob[64 * j] = pb; } }
#pragma unroll
        for (int o = 1; o < 64; o <<= 1) { sa += shx(sa, o, lane); sb2 += shx(sb2, o, lane); }
        if (lane < 16) { ssp[(size_t)r * 16 + lane] = (lane == 0) ? sa : 0.f; ssp[(size_t)r2 * 16 + lane] = (lane == 0) ? sb2 : 0.f; }
    }
}
__device__ __forceinline__ void rope_entry(float* rope, int idx) {
    const int pos = idx >> 7, c = idx & 127;
    const float inv = (float)exp2(-(double)c * (13.287712379549449 / 128.0));
    const float angf = (float)pos * inv;
    const double ang = (double)angf;
    const double kq = rint(ang * 0.63661977236758134308);
    double r = fma(-kq, 1.57079632679489655800e+00, ang); r = fma(-kq, 6.12323399573676603587e-17, r);
    const double r2 = r * r;
    double sn = 1.0 / 6227020800.0; sn = fma(sn, r2, -1.0 / 39916800.0); sn = fma(sn, r2, 1.0 / 362880.0); sn = fma(sn, r2, -1.0 / 5040.0); sn = fma(sn, r2, 1.0 / 120.0); sn = fma(sn, r2, -1.0 / 6.0); sn = fma(sn * r2, r, r);
    double cs = 1.0 / 479001600.0; cs = fma(cs, r2, -1.0 / 3628800.0); cs = fma(cs, r2, 1.0 / 40320.0); cs = fma(cs, r2, -1.0 / 720.0); cs = fma(cs, r2, 1.0 / 24.0); cs = fma(cs, r2, -0.5); cs = fma(cs, r2, 1.0);
    const int q = ((int)kq) & 3;
    const double c0 = (q == 0) ? cs : (q == 1) ? -sn : (q == 2) ? -cs : sn;
    const double s0 = (q == 0) ? sn : (q == 1) ? cs : (q == 2) ? -sn : -cs;
    *(f32x2*)(rope + (size_t)idx * 2) = (f32x2){(float)c0, (float)s0};
}

constexpr int BLK = 512;
__device__ __forceinline__ unsigned offb(unsigned row, unsigned ch) { return 256u * row + 16u * (ch ^ (((row & 3u) << 2) | ((row >> 2) & 3u))); }
__device__ __forceinline__ bf16x8 scale8s(bf16x8 v, float w) {
    const u32x4 x = __builtin_bit_cast(u32x4, v); u32x4 o;
    o.x = cvt_pk_bf16(bf_lo(x.x) * w, bf_hi(x.x) * w); o.y = cvt_pk_bf16(bf_lo(x.y) * w, bf_hi(x.y) * w);
    o.z = cvt_pk_bf16(bf_lo(x.z) * w, bf_hi(x.z) * w); o.w = cvt_pk_bf16(bf_lo(x.w) * w, bf_hi(x.w) * w);
    return __builtin_bit_cast(bf16x8, o);
}

__device__ __forceinline__ void chain_phase(LAS unsigned char* lds, const bf16_t* KF, const bf16_t* KW, const bf16_t* VT, bf16_t* ST, int S, int nseq) {
    int tid_ = threadIdx.x; asm volatile("" : "+v"(tid_));
    const int tid = tid_, wid = __builtin_amdgcn_readfirstlane(tid >> 6), lane = tid & 63, fr = lane & 15, fq = lane >> 4, wa = wid >> 1, wb = wid & 1;
    const unsigned ldsb = (unsigned)(size_t)lds;
    const int fragoff = (fr * 64 + fq * 16) ^ (((fr >> 3) & 1) << 5);
    const int sb = lane * 16, swz = sb ^ (((sb >> 9) & 1) << 5), dR = swz >> 6, dC = (swz & 63) >> 1;
    const int N = S / BLK, nst = (S - BLK) / 64;
    unsigned tra[2][2];
    { const unsigned q = (lane & 15) >> 2, p = lane & 3;
#pragma unroll
      for (int i = 0; i < 2; ++i)
#pragma unroll
          for (int t = 0; t < 2; ++t) tra[i][t] = offb(8u * fq + 4u * t + q, 2u * (2 * wa + i) + (p >> 1)) + 8u * (p & 1); }
    const int sub = blockIdx.x >> 3, pr = (int)(blockIdx.x & 7) + 8 * (sub >> 4);
    if (sub < 32 && pr < nseq * 4) {
        const int s4 = sub & 15, dvq = s4 & 3, dkh = (s4 >> 2) & 1, dir = s4 >> 3, h = pr & 3, sq = pr >> 2;
        const int seq0 = sq * S;
        const float lg = dir ? lg_b(h) : lg_f(h);
        const float d512 = __builtin_amdgcn_exp2f(lg * 512.0f);
        f32x4 acc[2][4];
#pragma unroll
        for (int i = 0; i < 2; ++i)
#pragma unroll
            for (int j = 0; j < 4; ++j) acc[i][j] = (f32x4){0.f, 0.f, 0.f, 0.f};
        const bf16_t* kg[2]; const bf16_t* vg[2];
#pragma unroll
        for (int jj = 0; jj < 2; ++jj) { const int p = 2 * wid + jj, row = 4 * (p & 7) + (lane >> 4), ch = (lane & 15) ^ (((row & 3) << 2) | ((row >> 2) & 3));
            kg[jj] = (dir ? KW : KF) + (size_t)(seq0 + 32 * (p >> 3) + row) * 1024 + 256 * h + 128 * dkh + 8 * ch;
            vg[jj] = VT + (size_t)(512 * h + 128 * dvq + 16 * (p >> 1) + dR) * SLAB + seq0 + 32 * (p & 1) + dC; }
        bf16_t* stbase = ST + ((size_t)(((sq * 4 + h) * 2 + dir) * (N - 1)) << 17) + (size_t)(128 * dvq + 64 * wb + fr) * 256 + 128 * dkh + 32 * wa + 4 * fq;
#define CH_DMA(u_) do { const int _u = (u_) < nst ? (u_) : nst - 1; const int _tb = dir ? (S - 64 * (_u + 1)) : 64 * _u; LAS unsigned char* _d = lds + ((u_) & 3) * 32768; \
        __builtin_amdgcn_global_load_lds((const unsigned*)(kg[0] + (size_t)_tb * 1024), (LAS unsigned*)(_d + (2 * wid) * 1024), 16, 0, 0); \
        __builtin_amdgcn_global_load_lds((const unsigned*)(kg[1] + (size_t)_tb * 1024), (LAS unsigned*)(_d + (2 * wid + 1) * 1024), 16, 0, 0); \
        __builtin_amdgcn_global_load_lds((const unsigned*)(vg[0] + _tb), (LAS unsigned*)(_d + 16384 + (2 * wid) * 1024), 16, 0, 0); \
        __builtin_amdgcn_global_load_lds((const unsigned*)(vg[1] + _tb), (LAS unsigned*)(_d + 16384 + (2 * wid + 1) * 1024), 16, 0, 0); } while (0)
        CH_DMA(0); CH_DMA(1); CH_DMA(2);
#pragma unroll 1
        for (int u = 0; u < nst; ++u) {
            asm volatile("s_waitcnt vmcnt(8)" ::: "memory");
            __builtin_amdgcn_s_barrier();
            asm volatile("" ::: "memory");
            CH_DMA(u + 3);
            LAS unsigned char* stg = lds + (u & 3) * 32768;
            {
                const unsigned kimg = ldsb + (u & 3) * 32768;
                bf16x8 v0[4], v1[4];
#pragma unroll
                for (int j = 0; j < 4; ++j) { v0[j] = *(const LAS bf16x8*)(stg + 16384 + ((4 * wb + j) * 2 + 0) * 1024 + fragoff); v1[j] = *(const LAS bf16x8*)(stg + 16384 + ((4 * wb + j) * 2 + 1) * 1024 + fragoff); }
                u32x2 a00, a01, a10, a11, b00, b01, b10, b11;
                asm volatile("ds_read_b64_tr_b16 %0, %8\n\tds_read_b64_tr_b16 %1, %9\n\tds_read_b64_tr_b16 %2, %10\n\tds_read_b64_tr_b16 %3, %11\n\t"
                             "ds_read_b64_tr_b16 %4, %8 offset:8192\n\tds_read_b64_tr_b16 %5, %9 offset:8192\n\tds_read_b64_tr_b16 %6, %10 offset:8192\n\tds_read_b64_tr_b16 %7, %11 offset:8192\n\ts_waitcnt lgkmcnt(0)"
                             : "=&v"(a00), "=&v"(a01), "=&v"(a10), "=&v"(a11), "=&v"(b00), "=&v"(b01), "=&v"(b10), "=&v"(b11)
                             : "v"(kimg + tra[0][0]), "v"(kimg + tra[0][1]), "v"(kimg + tra[1][0]), "v"(kimg + tra[1][1]) : "memory");
                const bf16x8 A0 = __builtin_bit_cast(bf16x8, (u32x4){a00.x, a00.y, a01.x, a01.y}), A1 = __builtin_bit_cast(bf16x8, (u32x4){a10.x, a10.y, a11.x, a11.y});
                const bf16x8 B0 = __builtin_bit_cast(bf16x8, (u32x4){b00.x, b00.y, b01.x, b01.y}), B1 = __builtin_bit_cast(bf16x8, (u32x4){b10.x, b10.y, b11.x, b11.y});
                __builtin_amdgcn_s_setprio(1);
#pragma unroll
                for (int j = 0; j < 4; ++j) { acc[0][j] = __builtin_amdgcn_mfma_f32_16x16x32_bf16(A0, v0[j], acc[0][j], 0, 0, 0); acc[1][j] = __builtin_amdgcn_mfma_f32_16x16x32_bf16(A1, v0[j], acc[1][j], 0, 0, 0); }
#pragma unroll
                for (int j = 0; j < 4; ++j) { acc[0][j] = __builtin_amdgcn_mfma_f32_16x16x32_bf16(B0, v1[j], acc[0][j], 0, 0, 0); acc[1][j] = __builtin_amdgcn_mfma_f32_16x16x32_bf16(B1, v1[j], acc[1][j], 0, 0, 0); }
                __builtin_amdgcn_s_setprio(0);
            }
            if (((u + 1) & 7) == 0) {
                const int kb = (u + 1) >> 3, slot = dir ? (N - 1 - kb) : (kb - 1);
                bf16_t* sp = stbase + ((size_t)slot << 17);
#pragma unroll
                for (int i = 0; i < 2; ++i)
#pragma unroll
                    for (int j = 0; j < 4; ++j) { const f32x4 sv = acc[i][j]; u32x2 w; w.x = f2bf_rne(sv.x) | (f2bf_rne(sv.y) << 16); w.y = f2bf_rne(sv.z) | (f2bf_rne(sv.w) << 16);
                        *(u32x2*)(sp + (size_t)(16 * j) * 256 + 16 * i) = w; }
#pragma unroll
                for (int i = 0; i < 2; ++i)
#pragma unroll
                    for (int j = 0; j < 4; ++j) acc[i][j] = acc[i][j] * d512;
            }
        }
#undef CH_DMA
        asm volatile("s_waitcnt vmcnt(0) lgkmcnt(0)" ::: "memory");
        __builtin_amdgcn_s_barrier();
        asm volatile("" ::: "memory");
    }
}

__device__ __forceinline__ void retention_phase(LAS unsigned char* lds, const bf16_t* Q, const bf16_t* Kb, const bf16_t* VT, const bf16_t* ST, bf16_t* A3s  , int S) {
    const int N = S / BLK;
    for (int item = blockIdx.x; item < (SLAB / 128) * 4; item += gridDim.x) {
        int tid_ = threadIdx.x; asm volatile("" : "+v"(tid_));
        const int tid = tid_, wid = __builtin_amdgcn_readfirstlane(tid >> 6), lane = tid & 63, wr = wid >> 2, wc = wid & 3, fr = lane & 15, fq = lane >> 4;
        const int fragoff = (fr * 64 + fq * 16) ^ (((fr >> 3) & 1) << 5);
        const int sb = lane * 16, swz = sb ^ (((sb >> 9) & 1) << 5), dR = swz >> 6, dC = (swz & 63) >> 1;
        LAS f32x2* RED = (LAS f32x2*)(lds);
        const int qpp = S / 128  , jj = item >> 3, pr = (item & 7) + 8 * (jj / qpp), qb = jj % qpp;
        const int h = pr & 3, sq = pr >> 2, seq0 = sq * S, row0 = seq0 + 128 * qb, qpos0 = 128 * qb, n = qpos0 / BLK, blk0 = seq0 + BLK * n;
        const float lf = lg_f(h), lb = lg_b(h);
        const int nF = (n > 0) ? 8 : 0, nB = (n < N - 1) ? 8 : 0, nsteps = 16 + nF + nB;
        bf16x8 qa[8];
        { const bf16_t* qp = Q + (size_t)(row0 + 16 * wid + fr) * 1024 + 256 * h + 8 * fq;
#pragma unroll
          for (int s = 0; s < 8; ++s) qa[s] = *(const bf16x8*)(qp + 32 * s); }
        f32x4 acc[4][8];
#pragma unroll
        for (int a = 0; a < 4; ++a)
#pragma unroll
            for (int b = 0; b < 8; ++b) acc[a][b] = (f32x4){0.f, 0.f, 0.f, 0.f};
        const bf16_t* kbase = Kb + (size_t)blk0 * 1024 + 256 * h;
        const bf16_t* vbase = VT + (size_t)(512 * h) * SLAB + blk0;
        const bf16_t* fbase = ST + ((size_t)(((sq * 4 + h) * 2 + 0) * (N - 1) + (n - 1)) << 17);
        const bf16_t* bbase = ST + ((size_t)(((sq * 4 + h) * 2 + 1) * (N - 1) + n) << 17);
        const unsigned lok = (unsigned)(dR * 1024 + dC) * 2u, lov = (unsigned)(dR * SLAB + dC) * 2u, los = (unsigned)(dR * 256 + dC) * 2u;
#define RT_ISSUE(st_) do { const int _b = (st_) % 3, _e = ((st_) < nsteps) ? (st_) : 0, _kt = (_e < 16) ? _e : 0; \
        _Pragma("unroll") for (int _j = 0; _j < 2; ++_j) { const int _st = 2 * wid + _j; \
            __builtin_amdgcn_global_load_lds((const unsigned*)((const char*)(kbase + (size_t)(32 * _kt + 16 * (_st >> 3)) * 1024 + 32 * (_st & 7)) + lok), (LAS unsigned*)(lds + _b * 16384 + _st * 1024), 16, 0, 0); } \
        if (_e < 16) { \
            _Pragma("unroll") for (int _j = 0; _j < 4; ++_j) { const int _st = 4 * wid + _j; \
                __builtin_amdgcn_global_load_lds((const unsigned*)((const char*)(vbase + (size_t)(16 * _st) * SLAB + 32 * _e) + lov), (LAS unsigned*)(lds + 49152 + _b * 32768 + _st * 1024), 16, 0, 0); } \
        } else { const bf16_t* _sb = (_e < 16 + nF) ? fbase + 32 * (_e - 16) : bbase + 32 * (_e - 16 - nF); \
            _Pragma("unroll") for (int _j = 0; _j < 4; ++_j) { const int _st = 4 * wid + _j; \
                __builtin_amdgcn_global_load_lds((const unsigned*)((const char*)(_sb + (size_t)(16 * _st) * 256) + los), (LAS unsigned*)(lds + 49152 + _b * 32768 + _st * 1024), 16, 0, 0); } } } while (0)
        const int qib = (qpos0 & (BLK - 1)) + 16 * wid + fr;
        const float df = __builtin_amdgcn_exp2f(lf * (float)(qib + 1)), db = __builtin_amdgcn_exp2f(lb * (float)(BLK - qib));
        asm volatile("s_waitcnt vmcnt(0)" ::: "memory");
        RT_ISSUE(0); RT_ISSUE(1);
#pragma unroll 1
        for (int st = 0; st < nsteps; ++st) {
            const int b = st % 3;
            asm volatile("s_waitcnt vmcnt(6)" ::: "memory");
            __builtin_amdgcn_s_barrier();
            asm volatile("" ::: "memory");
            RT_ISSUE(st + 2);
            LAS unsigned char* ps = lds + 147456;
            if (st < 16) {
                LAS unsigned char* ks = lds + b * 16384 + fragoff;
                {
                    f32x4 p0 = {0.f, 0.f, 0.f, 0.f}, p1 = {0.f, 0.f, 0.f, 0.f}; bf16x8 ka[4], kb[4];
#define RT_LDK(dst, t2_, s0_) do { _Pragma("unroll") for (int s = 0; s < 4; ++s) dst[s] = *(const LAS bf16x8*)(ks + ((t2_) * 8 + (s0_) + s) * 1024); } while (0)
#define RT_MMK(pp, src_, s0_) do { _Pragma("unroll") for (int s = 0; s < 4; ++s) pp = __builtin_amdgcn_mfma_f32_16x16x32_bf16(src_[s], qa[(s0_) + s], pp, 0, 0, 0); } while (0)
                    RT_LDK(ka, 0, 0); RT_LDK(kb, 0, 4); __builtin_amdgcn_sched_barrier(0);
                    __builtin_amdgcn_s_setprio(1);
                    RT_MMK(p0, ka, 0); RT_LDK(ka, 1, 0); __builtin_amdgcn_sched_barrier(0);
                    RT_MMK(p0, kb, 4); RT_LDK(kb, 1, 4); __builtin_amdgcn_sched_barrier(0);
                    RT_MMK(p1, ka, 0); RT_MMK(p1, kb, 4);
                    __builtin_amdgcn_s_setprio(0);
#undef RT_LDK
#undef RT_MMK
#pragma unroll
                    for (int t2 = 0; t2 < 2; ++t2) { f32x4 p = t2 ? p1 : p0;
                        const int dd = qib - (32 * st + 16 * t2 + 4 * fq);
#pragma unroll
                        for (int i = 0; i < 4; ++i) { const int d = dd - i; const float e = (d >= 0) ? lf * (float)d : lb * (float)(-d); p[i] *= __builtin_amdgcn_exp2f(e); }
                        const int ob = fr * 64 + (16 * t2 + 4 * fq) * 2;
                        u32x2 w; w.x = cvt_pk_bf16(p[0], p[1]); w.y = cvt_pk_bf16(p[2], p[3]);
                        *(LAS u32x2*)(ps + wid * 1024 + (ob ^ (((ob >> 9) & 1) << 5))) = w; }
                }
            } else {
                bf16x8 qv;
                switch (st & 7) { case 0: qv = qa[0]; break; case 1: qv = qa[1]; break; case 2: qv = qa[2]; break; case 3: qv = qa[3]; break;
                                  case 4: qv = qa[4]; break; case 5: qv = qa[5]; break; case 6: qv = qa[6]; break; default: qv = qa[7]; break; }
                *(LAS bf16x8*)(ps + wid * 1024 + fragoff) = scale8s(qv, (st < 16 + nF) ? df : db);
            }
            asm volatile("s_waitcnt lgkmcnt(0)" ::: "memory");
            __builtin_amdgcn_s_barrier();
            asm volatile("" ::: "memory");
            {
                bf16x8 pf[4], va[4], vb[4];
#pragma unroll
                for (int mt = 0; mt < 4; ++mt) pf[mt] = *(const LAS bf16x8*)(ps + (4 * wr + mt) * 1024 + fragoff);
#pragma unroll
                for (int nt2 = 0; nt2 < 4; ++nt2) va[nt2] = *(const LAS bf16x8*)(lds + 49152 + b * 32768 + (8 * wc + nt2) * 1024 + fragoff);
                __builtin_amdgcn_sched_barrier(0);
                __builtin_amdgcn_s_setprio(1);
#pragma unroll
                for (int nt2 = 0; nt2 < 4; ++nt2) vb[nt2] = *(const LAS bf16x8*)(lds + 49152 + b * 32768 + (8 * wc + 4 + nt2) * 1024 + fragoff);
#pragma unroll
                for (int nt2 = 0; nt2 < 4; ++nt2)
#pragma unroll
                    for (int mt = 0; mt < 4; ++mt) acc[mt][nt2] = __builtin_amdgcn_mfma_f32_16x16x32_bf16(va[nt2], pf[mt], acc[mt][nt2], 0, 0, 0);
                __builtin_amdgcn_sched_group_barrier(0x8, 1, 0); __builtin_amdgcn_sched_group_barrier(0x100, 4, 0); __builtin_amdgcn_sched_group_barrier(0x8, 15, 0);
                __builtin_amdgcn_sched_barrier(0);
#pragma unroll
                for (int nt2 = 0; nt2 < 4; ++nt2)
#pragma unroll
                    for (int mt = 0; mt < 4; ++mt) acc[mt][4 + nt2] = __builtin_amdgcn_mfma_f32_16x16x32_bf16(vb[nt2], pf[mt], acc[mt][4 + nt2], 0, 0, 0);
                __builtin_amdgcn_sched_barrier(0);
                __builtin_amdgcn_s_setprio(0);
            }
        }
#undef RT_ISSUE
        asm volatile("s_waitcnt vmcnt(0)" ::: "memory");
        __builtin_amdgcn_s_barrier();
        asm volatile("" ::: "memory");
        int fr_e = fr, fq_e = fq; asm volatile("" : "+v"(fr_e), "+v"(fq_e));
#pragma unroll
        for (int mt = 0; mt < 4; ++mt) { float s1 = 0.f, s2 = 0.f;
#pragma unroll
            for (int nt2 = 0; nt2 < 8; ++nt2) { const f32x4 v = acc[mt][nt2]; s1 += (v.x + v.y) + (v.z + v.w); s2 += (v.x * v.x + v.y * v.y) + (v.z * v.z + v.w * v.w); }
            { const int ln = fr_e + 16 * fq_e; s1 += shx(s1, 16, ln); s1 += shx(s1, 32, ln); s2 += shx(s2, 16, ln); s2 += shx(s2, 32, ln); }
            if (fq_e == 0) RED[(64 * wr + 16 * mt + fr_e) * 4 + wc] = (f32x2){s1, s2}; }
        asm volatile("s_waitcnt lgkmcnt(0)" ::: "memory");
        __builtin_amdgcn_s_barrier();
        asm volatile("" ::: "memory");
#pragma unroll
        for (int mt = 0; mt < 4; ++mt) { const int row = 64 * wr + 16 * mt + fr_e;
            const f32x2 a = RED[row * 4 + 0], b2 = RED[row * 4 + 1], c2 = RED[row * 4 + 2], d2 = RED[row * 4 + 3];
            const float mean = ((a.x + b2.x) + (c2.x + d2.x)) * (1.0f / 512.0f);
            float var = ((a.y + b2.y) + (c2.y + d2.y)) * (1.0f / 512.0f) - mean * mean; var = var > 0.f ? var : 0.f;
            const float rstd = __builtin_amdgcn_rsqf(var + EPS);
            bf16_t* gp = A3s + (size_t)(row0 + row) * DVW + 512 * h + 128 * wc + 4 * fq_e;
            u32x2 gwv[8];
#pragma unroll
            for (int nt2 = 0; nt2 < 8; ++nt2) gwv[nt2] = *(const u32x2*)(gp + 16 * nt2);
            EPI_FENCE();
#pragma unroll
            for (int nt2 = 0; nt2 < 8; ++nt2) { const u32x2 gw = gwv[nt2]; const f32x4 v = acc[mt][nt2];
                u32x2 w; w.x = cvt_pk_bf16((v.x - mean) * rstd * bf_lo(gw.x), (v.y - mean) * rstd * bf_hi(gw.x)); w.y = cvt_pk_bf16((v.z - mean) * rstd * bf_lo(gw.y), (v.w - mean) * rstd * bf_hi(gw.y));
                *(u32x2*)(gp + 16 * nt2) = w; }
            EPI_FENCE(); }
        asm volatile("s_waitcnt lgkmcnt(0)" ::: "memory");
        __builtin_amdgcn_s_barrier();
        asm volatile("" ::: "memory");
    }
}

struct Args { const float* in[17]; float* out; unsigned char* ws; };
typedef const __attribute__((address_space(4))) Args* ArgsP;
__device__ __forceinline__ ArgsP largs() { ArgsP p = (ArgsP)__builtin_amdgcn_kernarg_segment_ptr(); asm volatile("" : "+s"(p)); return p; }
#define WSB(off) ((bf16_t*)(ws + (off)))

__global__ void __launch_bounds__(512, 2) mega_fwd(Args a_unused) {
    extern __shared__ __attribute__((aligned(16))) unsigned char lds_raw[];
    LAS unsigned char* lds = (LAS unsigned char*)lds_raw;
    const int G = gridDim.x, bx = blockIdx.x;
#define PH_IDS() int tid = threadIdx.x; asm volatile("" : "+v"(tid)); const int lane = tid & 63, wave = __builtin_amdgcn_readfirstlane(tid >> 6), gw = bx * 8 + wave, ngw = G * 8; (void)lane; (void)gw; (void)ngw
    { const int tid = threadIdx.x;
      volatile LAS unsigned* MISC = (volatile LAS unsigned*)(lds + MISC_OFF); if (tid < 32) MISC[tid] = 0u; }
    __syncthreads();
    XcdBarrier bar = xcd_barrier_post((unsigned*)(largs()->ws + WS_CTL) + CW_BAR, (volatile LAS unsigned*)(lds + MISC_OFF) + 8);
#define GRID_BAR() xcd_barrier(bar)

    {
        PH_IDS(); ArgsP a = largs(); unsigned char* ws = a->ws;
        LAS float* scr = (LAS float*)(lds + wave * 16384);
        constexpr int I_WIN = 96 * 16, I_WOUT = 32 * 16, I_UP = 128 * 16, I_DN = 32 * 64, I_QKG = 128 * 16, I_V = 64 * 16, I_O = 32 * 32;
        constexpr int NITEMS = I_WIN + I_WOUT + 2 * I_UP + 2 * I_DN + I_QKG + I_V + I_O;
        const int nit = (G > 128) ? NITEMS - (I_O + I_UP + I_DN) : NITEMS;
        for (int it = gw; it < nit; it += ngw) {
            int r = it;
            if (r < I_WIN) { const int nb = r % 96, kb = r / 96, n0 = 32 * nb, pn = n0 >> 8, j = n0 & 255;
                const int src = (pn < 8) ? ((j >> 7) ? 2048 : 0) + 128 * pn + (j & 127) : 1024 + (n0 - 2048);
                transpose_item(a->in[3], 1024, 3072, a->in[2], WSB(WS_WIN), n0, src, 64 * kb, scr, lane); continue; } r -= I_WIN;
            if (r < I_WOUT) { const int nb = r % 32, kb = r / 32; transpose_item(a->in[6], 1024, 1024, nullptr, WSB(WS_WOUT), 32 * nb, 32 * nb, 64 * kb, scr, lane); continue; } r -= I_WOUT;
            if (r < I_UP) { const int nb = r % 128, kb = r / 128; transpose_item(a->in[8], 1024, 4096, a->in[7], WSB(WS_WUP0), 32 * nb, 32 * nb, 64 * kb, scr, lane); continue; } r -= I_UP;
            if (r < I_DN) { const int nb = r % 32, kb = r / 32; transpose_item(a->in[9], 4096, 1024, nullptr, WSB(WS_WDN0), 32 * nb, 32 * nb, 64 * kb, scr, lane); continue; } r -= I_DN;
            if (r < I_QKG) { const int nb = r % 128, kb = r / 128, n0 = 32 * nb; transpose_item(a->in[11], 1024, 6144, a->in[10], WSB(WS_WQKG), n0, n0 < 2048 ? n0 : n0 + 2048, 64 * kb, scr, lane); continue; } r -= I_QKG;
            if (r < I_V) { const int nb = r % 64, kb = r / 64; transpose_item(a->in[11], 1024, 6144, a->in[10], WSB(WS_WV), 32 * nb, 2048 + 32 * nb, 64 * kb, scr, lane); continue; } r -= I_V;
            if (r < I_O) { const int nb = r % 32, kb = r / 32; transpose_item(a->in[12], 2048, 1024, nullptr, WSB(WS_WO), 32 * nb, 32 * nb, 64 * kb, scr, lane); continue; } r -= I_O;
            if (r < I_UP) { const int nb = r % 128, kb = r / 128; transpose_item(a->in[14], 1024, 4096, a->in[13], WSB(WS_WUP1), 32 * nb, 32 * nb, 64 * kb, scr, lane); continue; } r -= I_UP;
            { const int nb = r % 32, kb = r / 32; transpose_item(a->in[15], 4096, 1024, nullptr, WSB(WS_WDN1), 32 * nb, 32 * nb, 64 * kb, scr, lane); }
        }
        float* rope = (float*)(ws + WS_ROPE);
        for (int idx = bx * 512 + tid; idx < 4096 * 128; idx += G * 512) rope_entry(rope, idx);
        xb_prep(a->in[0], WSB(WS_XB), (float*)(ws + WS_SSP), gw, ngw, lane);
    }
    GRID_BAR();
    if (gridDim.y == 7777u) cg::this_grid().sync();

    for (int g = 0; g < 2; ++g) {
        const int S = g ? 2048 : 4096;
        { ArgsP a = largs(); unsigned char* ws = a->ws;
          pg8::StaticOrder<MG, 3072> so; so.init(G, bx); EpiConvIn E{WSB(WS_U), WSB(WS_GB), (const float*)(ws + WS_SSP + (size_t)(2 * g) * MiB)}; pg8::gemm_phase<D, D, D>(lds, g ? (const bf16_t*)(a->out + (size_t)MG * D) : WSB(WS_XB), WSB(WS_WIN), so, E); }
        GRID_BAR();
        {
            PH_IDS(); ArgsP a = largs(); unsigned char* ws = a->ws;
            const float* cw = a->in[4]; const float* cbv = a->in[5]; const bf16_t* Ub = WSB(WS_U); const bf16_t* GBb = WSB(WS_GB); bf16_t* A2 = WSB(WS_A2);
            const int ch0 = bx * 512 + tid, c = (ch0 & 127) * 8, tstep = (G * 512) >> 7;
            const f32x4 w0a = *(const f32x4*)(cw + c), w0b = *(const f32x4*)(cw + c + 4), w1a = *(const f32x4*)(cw + D + c), w1b = *(const f32x4*)(cw + D + c + 4), w2a = *(const f32x4*)(cw + 2 * D + c), w2b = *(const f32x4*)(cw + 2 * D + c + 4);
            const f32x4 ba = *(const f32x4*)(cbv + c), bb = *(const f32x4*)(cbv + c + 4);
            for (int t = ch0 >> 7; t < MG; t += tstep) {
                const int pos = t & (S - 1);
                const u32x4 z4 = {0u, 0u, 0u, 0u};
                const u32x4 um = (pos > 0) ? *(const u32x4*)(Ub + (size_t)(t - 1) * D + c) : z4;
                const u32x4 u0 = *(const u32x4*)(Ub + (size_t)t * D + c);
                const u32x4 up = (pos < S - 1) ? *(const u32x4*)(Ub + (size_t)(t + 1) * D + c) : z4;
                const u32x4 gb = __builtin_nontemporal_load((const u32x4*)(GBb + (size_t)t * D + c));
                f32x4 za, zb;
                za.x = ba.x + w0a.x * bf_lo(um.x) + w1a.x * bf_lo(u0.x) + w2a.x * bf_lo(up.x); za.y = ba.y + w0a.y * bf_hi(um.x) + w1a.y * bf_hi(u0.x) + w2a.y * bf_hi(up.x);
                za.z = ba.z + w0a.z * bf_lo(um.y) + w1a.z * bf_lo(u0.y) + w2a.z * bf_lo(up.y); za.w = ba.w + w0a.w * bf_hi(um.y) + w1a.w * bf_hi(u0.y) + w2a.w * bf_hi(up.y);
                zb.x = bb.x + w0b.x * bf_lo(um.z) + w1b.x * bf_lo(u0.z) + w2b.x * bf_lo(up.z); zb.y = bb.y + w0b.y * bf_hi(um.z) + w1b.y * bf_hi(u0.z) + w2b.y * bf_hi(up.z);
                zb.z = bb.z + w0b.z * bf_lo(um.w) + w1b.z * bf_lo(u0.w) + w2b.z * bf_lo(up.w); zb.w = bb.w + w0b.w * bf_hi(um.w) + w1b.w * bf_hi(u0.w) + w2b.w * bf_hi(up.w);
                za.x *= bf_lo(gb.x); za.y *= bf_hi(gb.x); za.z *= bf_lo(gb.y); za.w *= bf_hi(gb.y); zb.x *= bf_lo(gb.z); zb.y *= bf_hi(gb.z); zb.z *= bf_lo(gb.w); zb.w *= bf_hi(gb.w);
                *(u32x4*)(A2 + (size_t)t * D + c) = pack8(za, zb);
            }
        }
        GRID_BAR();
        { ArgsP a = largs(); unsigned char* ws = a->ws;
          pg8::StaticOrder<MG, D> so; so.init(G, bx);
          EpiRes E{a->in[g], WSB(WS_XB), (float*)(ws + WS_SSP + (size_t)(2 * g + 1) * MiB)}; pg8::gemm_phase<D, D, D>(lds, WSB(WS_A2), WSB(WS_WOUT), so, E); }
        GRID_BAR();
        { ArgsP a = largs(); unsigned char* ws = a->ws;
          pg8::StaticOrder<MG, FF> so; so.init(G, bx); EpiUp E{WSB(WS_HID), (const float*)(ws + WS_SSP + (size_t)(2 * g + 1) * MiB)}; pg8::gemm_phase<D, D, D>(lds, WSB(WS_XB), WSB(WS_WUP0), so, E); }
        GRID_BAR();
        { ArgsP a = largs(); unsigned char* ws = a->ws;
          pg8::StaticOrder<MG, D> so; so.init(G, bx); EpiRes E{nullptr, WSB(WS_XB), (float*)(ws + WS_SSP + (size_t)(2 * g) * MiB)}; pg8::gemm_phase<FF, FF, FF>(lds, WSB(WS_HID), WSB(WS_WDN0), so, E); }
        GRID_BAR();
        for (int sl = 0; sl < 2; ++sl) {
            { ArgsP a = largs(); unsigned char* ws = a->ws;
              const bf16_t* XBs = WSB(WS_XB) + (size_t)sl * SLAB * D; const float* sps = (const float*)(ws + WS_SSP + (size_t)(2 * g) * MiB) + (size_t)sl * SLAB * 16;
              QkvOrder so; so.init(G, bx);
              bf16_t* KFp = (bf16_t*)(a->out + (size_t)g * MG * D); bf16_t* KWp = KFp + (size_t)SLAB * 1024;
              EpiQKVG E{EpiQKG{WSB(WS_Q), WSB(WS_K), KFp, KWp, WSB(WS_A3) + (size_t)sl * SLAB * DVW, sps, (const float*)(ws + WS_ROPE), S - 1}, EpiVT{WSB(WS_VT), sps}};
              pg8::gemm_phase<D, D, D>(lds, XBs, WSB(WS_WQKG), so, E, WSB(WS_WV), XBs); }
            GRID_BAR();
            { ArgsP a = largs(); unsigned char* ws = a->ws;
              const bf16_t* KFp = (const bf16_t*)(a->out + (size_t)g * MG * D);
              chain_phase(lds, KFp, KFp + (size_t)SLAB * 1024, WSB(WS_VT), WSB(WS_ST), S, SLAB / S);
              if (g == 0 && bx >= 128) {
                  PH_IDS(); (void)gw; (void)ngw;
                  const size_t ro = (size_t)sl * SLAB;
                  xb_prep<true>(a->in[1] + ro * D, (bf16_t*)(a->out + (size_t)MG * D) + ro * D, (float*)(ws + WS_SSP + 2 * MiB) + ro * 16, (bx - 128) * 8 + wave, (G - 128) * 8, lane, SLAB);
                  LAS float* scr = (LAS float*)(lds + wave * 16384);
                  const int iw = (bx - 128) * 8 + wave, niw = (G - 128) * 8;
                  if (sl == 0) { for (int it = iw; it < 32 * 32 + 128 * 16; it += niw) {
                          if (it < 32 * 32) { const int nb = it % 32, kb = it / 32; transpose_item<true>(a->in[12], 2048, 1024, nullptr, WSB(WS_WO), 32 * nb, 32 * nb, 64 * kb, scr, lane); }
                          else { const int r = it - 32 * 32, nb = r % 128, kb = r / 128; transpose_item<true>(a->in[14], 1024, 4096, a->in[13], WSB(WS_WUP1), 32 * nb, 32 * nb, 64 * kb, scr, lane); } } }
                  else { for (int it = iw; it < 32 * 64; it += niw) { const int nb = it % 32, kb = it / 32; transpose_item<true>(a->in[15], 4096, 1024, nullptr, WSB(WS_WDN1), 32 * nb, 32 * nb, 64 * kb, scr, lane); } } } }
            GRID_BAR();
            { ArgsP a = largs(); unsigned char* ws = a->ws;
              retention_phase(lds, WSB(WS_Q), WSB(WS_K), WSB(WS_VT), WSB(WS_ST), WSB(WS_A3) + (size_t)sl * SLAB * DVW, S); }
            GRID_BAR();
        }
        { ArgsP a = largs(); unsigned char* ws = a->ws;
          pg8::StaticOrder<MG, D> so; so.init(G, bx); EpiRes E{nullptr, WSB(WS_XB), (float*)(ws + WS_SSP + (size_t)(2 * g + 1) * MiB)}; pg8::gemm_phase<DVW, DVW, DVW>(lds, WSB(WS_A3), WSB(WS_WO), so, E); }
        GRID_BAR();
        { ArgsP a = largs(); unsigned char* ws = a->ws;
          pg8::StaticOrder<MG, FF> so; so.init(G, bx); EpiUp E{WSB(WS_HID), (const float*)(ws + WS_SSP + (size_t)(2 * g + 1) * MiB)}; pg8::gemm_phase<D, D, D>(lds, WSB(WS_XB), WSB(WS_WUP1), so, E); }
        GRID_BAR();
        { ArgsP a = largs(); unsigned char* ws = a->ws;
          pg8::StaticOrder<MG, D> so; so.init(G, bx);
          EpiFinal E{WSB(WS_XB), a->out + (size_t)g * MG * D, (float*)(ws + WS_SSP + (size_t)(2 * g) * MiB), a->in[16], (unsigned*)(ws + WS_CTL) + CW_FIN + g * 64 * 64};
          pg8::gemm_phase<FF, FF, FF>(lds, WSB(WS_HID), WSB(WS_WDN1), so, E); }
        if (g == 0) GRID_BAR();
    }
}

extern "C" void kernel_launch(void* const* d_in, const int* in_sizes, int n_in, void* d_out, int out_size, void* d_ws, size_t ws_size, hipStream_t stream) {
    static int grid = 0;
    if (grid == 0) {
        if (n_in != 17 || out_size != 2 * MG * D || ws_size < WS_END) { fprintf(stderr, "kernel_launch: unexpected shapes (n_in %d out %d ws %zu); nothing launched\n", n_in, out_size, ws_size); grid = -1; return; }
        int dev = 0, cus = 0, per_cu = 0;
        if (hipGetDevice(&dev) != hipSuccess || hipDeviceGetAttribute(&cus, hipDeviceAttributeMultiprocessorCount, dev) != hipSuccess) { grid = -1; return; }
        if (hipFuncSetAttribute((const void*)mega_fwd, hipFuncAttributeMaxDynamicSharedMemorySize, LDS_BYTES) != hipSuccess) { fprintf(stderr, "kernel_launch: hipFuncSetAttribute failed\n"); grid = -1; return; }
        if (hipOccupancyMaxActiveBlocksPerMultiprocessor(&per_cu, (const void*)mega_fwd, 512, LDS_BYTES) != hipSuccess || per_cu < 1) { fprintf(stderr, "kernel_launch: occupancy query says %d blocks/CU\n", per_cu); (void)hipGetLastError(); grid = -1; return; }
        grid = cus;
    }
    if (grid < 0) return;
    (void)hipMemsetAsync((char*)d_ws + WS_CTL, 0, CTL_ZERO_BYTES, stream);
    Args a{};
    for (int i = 0; i < 17; ++i) a.in[i] = (const float*)d_in[i];
    a.out = (float*)d_out; a.ws = (unsigned char*)d_ws;
    void* args[] = {&a};
    hipError_t e = hipLaunchCooperativeKernel((const void*)mega_fwd, dim3(grid), dim3(512), args, LDS_BYTES, stream);
    if (e != hipSuccess) fprintf(stderr, "cooperative launch failed: %s (grid %d)\n", hipGetErrorString(e), grid);
}
```
